# Optimizing an MI355X kernel written in HIP

```python
import math
import jax, jax.numpy as jnp
from jax import lax
import numpy as np

D_MODEL = 1024
BATCH = 8
SEQ = 4096
DEPTH = 1

MIX_WIDTH = D_MODEL
DIFF_WIDTH = MIX_WIDTH // 2
RET_WIDTH = MIX_WIDTH - DIFF_WIDTH
N_DIFF_HEADS = 4
DIFF_V_DIM = DIFF_WIDTH // N_DIFF_HEADS
DIFF_QK_DIM = DIFF_V_DIM // 2
N_RET_HEADS = 4
RET_V_DIM = RET_WIDTH // N_RET_HEADS
RET_QK_DIM = RET_V_DIM // 2
DIFF_QK_COLS = N_DIFF_HEADS * 2 * DIFF_QK_DIM
RET_QK_COLS = N_RET_HEADS * RET_QK_DIM
SPLIT_SIZES = (DIFF_QK_COLS, DIFF_QK_COLS, DIFF_WIDTH, RET_QK_COLS, RET_QK_COLS, RET_WIDTH, RET_WIDTH)
SPLIT_POINTS = (512, 1024, 1536, 1792, 2048, 2560)
IN_COLS = 3072

ROPE_THETA = 500000.0
ROPE_FRACTION = 4
RET_THETA = 10000.0
Q_BLOCK = 128
RET_CHUNK = 128

N_KEYS = 128
N_EXPERTS = N_KEYS * N_KEYS
PEER_HEADS = 8
PEER_TOPK = 16
PEER_KEY_DIM = 256
PEER_TOKEN_BLOCK = 128

EPS = 1e-6

kernel_name = 'hybrid_diffattn_retnet_peer_encoder'


def rmsnorm(x, g):
    x32 = x.astype(jnp.float32)
    y = x32 * lax.rsqrt(jnp.mean(x32 * x32, axis=-1, keepdims=True) + EPS)
    return (y * g.astype(jnp.float32)).astype(x.dtype)


def group_norm(o, g):
    mu = jnp.mean(o, axis=-1, keepdims=True)
    c = o - mu
    var = jnp.mean(c * c, axis=-1, keepdims=True)
    return c * lax.rsqrt(var + EPS) * g.astype(jnp.float32)


def rotate_prefix(x, pos, inv_freq):
    half = inv_freq.shape[0]
    rot = 2 * half
    ang = pos[:, None] * inv_freq[None, :]
    shape = (1, pos.shape[0]) + (1,) * (x.ndim - 3) + (half,)
    cos = jnp.cos(ang).reshape(shape)
    sin = jnp.sin(ang).reshape(shape)
    xf = x.astype(jnp.float32)
    x1 = xf[..., :half]
    x2 = xf[..., half:rot]
    out = jnp.concatenate([x1 * cos - x2 * sin, x2 * cos + x1 * sin, xf[..., rot:]], axis=-1)
    return out.astype(x.dtype)


def diff_attention(q, k, v, lam):
    B, S, H, _, d = q.shape
    nb = S // Q_BLOCK
    scale = d ** -0.5
    q_blocks = q.reshape(B, nb, Q_BLOCK, H, 2, d).transpose(1, 0, 2, 3, 4, 5)

    def one_block(qb):
        s = jnp.einsum('bqhmd,bkhmd->bhmqk', qb, k).astype(jnp.float32) * scale
        p = jax.nn.softmax(s, axis=-1)
        a = p[:, :, 0] - lam * p[:, :, 1]
        return jnp.einsum('bhqk,bkhe->bqhe', a.astype(v.dtype), v)

    o = lax.map(one_block, q_blocks)
    return o.transpose(1, 0, 2, 3, 4).reshape(B, S, H, v.shape[-1])


def retention_direction(q, k, v, log_gamma, strict):
    B, S, H, dk = q.shape
    dv = v.shape[-1]
    C = RET_CHUNK
    nc = S // C
    qc = q.reshape(B, nc, C, H, dk).transpose(1, 0, 3, 2, 4)
    kc = k.reshape(B, nc, C, H, dk).transpose(1, 0, 3, 2, 4)
    vc = v.reshape(B, nc, C, H, dv).transpose(1, 0, 3, 2, 4)
    idx = jnp.arange(C, dtype=jnp.float32)
    dist = idx[:, None] - idx[None, :]
    mask = (dist > 0) if strict else (dist >= 0)
    lg = log_gamma[:, None, None]
    decay_in = jnp.where(mask[None], jnp.exp(lg * jnp.maximum(dist, 0.0)[None]), 0.0)
    q_decay = jnp.exp(log_gamma[:, None] * (idx + 1.0)[None])[None, :, :, None]
    k_decay = jnp.exp(log_gamma[:, None] * (C - 1.0 - idx)[None])[None, :, :, None]
    chunk_decay = jnp.exp(log_gamma * C)[None, :, None, None]

    def step(state, inp):
        qi, ki, vi = inp
        inner = jnp.einsum('bhid,bhjd->bhij', qi, ki) * decay_in[None]
        o = jnp.einsum('bhij,bhjv->bhiv', inner, vi) + jnp.einsum('bhid,bhdv->bhiv', qi * q_decay, state)
        state = state * chunk_decay + jnp.einsum('bhjd,bhjv->bhdv', ki * k_decay, vi)
        return state, o

    state0 = jnp.zeros((B, H, dk, dv), jnp.float32)
    _, o = lax.scan(step, state0, (qc, kc, vc))
    return o.transpose(1, 0, 3, 2, 4).reshape(B, S, H, dv)


def peer_ffn(xn, w_query, sub_keys, expert_down, expert_up):
    B, S, D = xn.shape
    T = B * S
    nb = T // PEER_TOKEN_BLOCK
    x_blocks = xn.reshape(nb, PEER_TOKEN_BLOCK, D)

    def one_block(xb):
        tb = xb.shape[0]
        q = (xb @ w_query).reshape(tb, PEER_HEADS, 2, PEER_KEY_DIM // 2)
        s = jnp.einsum('thpd,hpnd->thpn', q, sub_keys).astype(jnp.float32)
        top_s, top_i = lax.top_k(s, PEER_TOPK)
        cand_s = (top_s[:, :, 0, :, None] + top_s[:, :, 1, None, :]).reshape(tb, PEER_HEADS, PEER_TOPK * PEER_TOPK)
        cand_i = (top_i[:, :, 0, :, None] * N_KEYS + top_i[:, :, 1, None, :]).reshape(tb, PEER_HEADS, PEER_TOPK * PEER_TOPK)
        best_s, pos = lax.top_k(cand_s, PEER_TOPK)
        eid = jnp.take_along_axis(cand_i, pos, axis=-1)
        gate = jax.nn.softmax(best_s, axis=-1)
        u = jnp.take(expert_down, eid, axis=0)
        act = jax.nn.gelu(jnp.einsum('thkd,td->thk', u, xb).astype(jnp.float32), approximate=False)
        v = jnp.take(expert_up, eid, axis=0)
        return jnp.einsum('thk,thkd->td', (gate * act).astype(v.dtype), v)

    out = lax.map(one_block, x_blocks)
    return out.reshape(B, S, D).astype(xn.dtype)


def setup_inputs(seed: int = 0) -> dict:
    key = jax.random.key(seed)
    ks = jax.random.split(key, 16)
    f32 = jnp.float32
    nrm = jax.random.normal
    x = nrm(ks[0], (BATCH, SEQ, D_MODEL), f32)
    attn_norm_g = 1.0 + 0.02 * nrm(ks[1], (DEPTH, D_MODEL), f32)
    w_in = nrm(ks[2], (DEPTH, D_MODEL, IN_COLS), f32) * D_MODEL ** -0.5
    diff_lambda = 0.1 * nrm(ks[3], (DEPTH, 4, DIFF_QK_DIM), f32)
    diff_norm_g = 1.0 + 0.02 * nrm(ks[4], (DEPTH, DIFF_V_DIM), f32)
    gammas = 1.0 - jnp.exp2(-5.0 - jnp.arange(N_RET_HEADS, dtype=f32))
    base = jnp.log(-jnp.log(gammas))
    ret_log_decay = base[None, None, :] + 0.05 * nrm(ks[5], (DEPTH, 2, N_RET_HEADS), f32)
    ret_norm_g = 1.0 + 0.02 * nrm(ks[6], (DEPTH, N_RET_HEADS, RET_V_DIM), f32)
    w_out = nrm(ks[7], (DEPTH, MIX_WIDTH, D_MODEL), f32) * MIX_WIDTH ** -0.5
    ffn_norm_g = 1.0 + 0.02 * nrm(ks[8], (DEPTH, D_MODEL), f32)
    peer_w_query = nrm(ks[9], (DEPTH, D_MODEL, PEER_HEADS * PEER_KEY_DIM), f32) * D_MODEL ** -0.5
    peer_sub_keys = nrm(ks[10], (DEPTH, PEER_HEADS, 2, N_KEYS, PEER_KEY_DIM // 2), f32) * (PEER_KEY_DIM // 2) ** -0.5
    peer_u = nrm(ks[11], (DEPTH, N_EXPERTS, D_MODEL), f32) * D_MODEL ** -0.5
    peer_v = nrm(ks[12], (DEPTH, N_EXPERTS, D_MODEL), f32) * PEER_HEADS ** -0.5
    final_norm_g = 1.0 + 0.02 * nrm(ks[13], (D_MODEL,), f32)
    return {'x': x, 'attn_norm_g': attn_norm_g, 'w_in': w_in, 'diff_lambda': diff_lambda,
            'diff_norm_g': diff_norm_g, 'ret_log_decay': ret_log_decay, 'ret_norm_g': ret_norm_g,
            'w_out': w_out, 'ffn_norm_g': ffn_norm_g, 'peer_w_query': peer_w_query,
            'peer_sub_keys': peer_sub_keys, 'peer_u': peer_u, 'peer_v': peer_v,
            'final_norm_g': final_norm_g}


def reference(x, attn_norm_g, w_in, diff_lambda, diff_norm_g, ret_log_decay, ret_norm_g,
              w_out, ffn_norm_g, peer_w_query, peer_sub_keys, peer_u, peer_v, final_norm_g):
    B, S, _ = x.shape
    pos = jnp.arange(S, dtype=jnp.float32)
    rot_dim = DIFF_QK_DIM // ROPE_FRACTION
    rope_inv = jnp.power(jnp.float32(ROPE_THETA), -jnp.arange(rot_dim // 2, dtype=jnp.float32) * 2.0 / rot_dim)
    ret_inv = 1.0 / jnp.power(jnp.float32(RET_THETA), jnp.linspace(0.0, 1.0, RET_QK_DIM // 2, dtype=jnp.float32))

    for l in range(DEPTH):
        lambda_init = 0.8 - 0.6 * math.exp(-0.3 * l)
        h = rmsnorm(x, attn_norm_g[l])
        proj = h @ w_in[l]
        dq, dk, dv, rq, rk, rv, rg = jnp.split(proj, SPLIT_POINTS, axis=-1)

        dq = rotate_prefix(dq.reshape(B, S, N_DIFF_HEADS, 2, DIFF_QK_DIM), pos, rope_inv)
        dk = rotate_prefix(dk.reshape(B, S, N_DIFF_HEADS, 2, DIFF_QK_DIM), pos, rope_inv)
        dv = dv.reshape(B, S, N_DIFF_HEADS, DIFF_V_DIM)
        lam_p = diff_lambda[l].astype(jnp.float32)
        lam = jnp.exp(jnp.sum(lam_p[0] * lam_p[1])) - jnp.exp(jnp.sum(lam_p[2] * lam_p[3])) + lambda_init
        a = diff_attention(dq, dk, dv, lam)
        a = rmsnorm(a, diff_norm_g[l]).astype(jnp.float32) * (1.0 - lambda_init)
        a = a.reshape(B, S, DIFF_WIDTH)

        rq = rotate_prefix(rq.reshape(B, S, N_RET_HEADS, RET_QK_DIM), pos, ret_inv).astype(jnp.float32)
        rk = rotate_prefix(rk.reshape(B, S, N_RET_HEADS, RET_QK_DIM), pos, ret_inv).astype(jnp.float32) * RET_QK_DIM ** -0.5
        rv = rv.reshape(B, S, N_RET_HEADS, RET_V_DIM).astype(jnp.float32)
        log_gamma = -jnp.exp(ret_log_decay[l].astype(jnp.float32))
        r_fwd = retention_direction(rq, rk, rv, log_gamma[0], False)
        r_bwd = retention_direction(rq[:, ::-1], rk[:, ::-1], rv[:, ::-1], log_gamma[1], True)[:, ::-1]
        r = group_norm(r_fwd + r_bwd, ret_norm_g[l]).reshape(B, S, RET_WIDTH)
        r = jax.nn.silu(rg.astype(jnp.float32)) * r

        mix = jnp.concatenate([a, r], axis=-1).astype(x.dtype)
        x = x + mix @ w_out[l]

        x = x + peer_ffn(rmsnorm(x, ffn_norm_g[l]), peer_w_query[l], peer_sub_keys[l], peer_u[l], peer_v[l])

    return rmsnorm(x, final_norm_g)
```

```cpp
#include <hip/hip_runtime.h>
#include <hip/hip_cooperative_groups.h>
#include <stdint.h>
#include <cstdio>

namespace {
constexpr int T = 32768, S = 4096, NB = 8, DM = 1024, INC = 3072;
constexpr float EPS = 1e-6f;
typedef unsigned short bf16_t;
typedef short bf16x8 __attribute__((ext_vector_type(8)));
typedef float f32x4 __attribute__((ext_vector_type(4)));
typedef float f32x2 __attribute__((ext_vector_type(2)));
typedef unsigned u32x4 __attribute__((ext_vector_type(4)));
typedef unsigned u32x2 __attribute__((ext_vector_type(2)));
#define LAS __attribute__((address_space(3)))

__device__ __forceinline__ float bf2f(bf16_t v) { return __uint_as_float(((unsigned)v) << 16); }
__device__ __forceinline__ bf16_t f2bf(float f) { unsigned u = __float_as_uint(f); u += 0x7fffu + ((u >> 16) & 1u); return (bf16_t)(u >> 16); }
__device__ __forceinline__ unsigned cvt_pk_bf16(float lo, float hi) { unsigned r; asm volatile("v_cvt_pk_bf16_f32 %0, %1, %2" : "=v"(r) : "v"(lo), "v"(hi)); return r; }
__device__ __forceinline__ int otid() { int t = threadIdx.x; asm volatile("" : "+v"(t)); return t; }
__device__ __forceinline__ float wave_sum(float v) { for (int o = 32; o > 0; o >>= 1) v += __shfl_xor(v, o); return v; }
__device__ __forceinline__ float wave_max(float v) { for (int o = 32; o > 0; o >>= 1) v = fmaxf(v, __shfl_xor(v, o)); return v; }

constexpr size_t MB = 1024ull * 1024ull, KB = 1024ull;
constexpr size_t OFF_QD = 0, OFF_KD = 32 * MB, OFF_VD = 64 * MB, OFF_RQ = 96 * MB, OFF_RK = 112 * MB, OFF_RV = 128 * MB, OFF_RG = 160 * MB;
constexpr size_t OFF_PART = 0;
constexpr size_t OFF_Q = 0;
constexpr size_t OFF_XB = 420 * MB;
constexpr size_t OFF_MIX = 192 * MB;
constexpr size_t OFF_X1B = 256 * MB;
constexpr size_t OFF_PO = 256 * MB;
constexpr size_t OFF_ST = 256 * MB;
constexpr size_t OFF_SST = 320 * MB;
constexpr size_t OFF_EID = 320 * MB, OFF_GATE = 336 * MB, OFF_HW = 352 * MB;
constexpr size_t OFF_WIN = 368 * MB, OFF_WOUT = 374 * MB, OFF_WQ = 376 * MB, OFF_KEYS = 380 * MB;
constexpr size_t OFF_U8 = 381 * MB, OFF_V8 = 397 * MB, OFF_USC = 413 * MB;
constexpr size_t OFF_ROPED = 414 * MB, OFF_ROPER = 414 * MB + 256 * KB;
constexpr size_t OFF_RSTD0 = 416 * MB, OFF_SSQ1 = 416 * MB + 128 * KB, OFF_RSTD1 = 416 * MB + 256 * KB, OFF_LAM = 416 * MB + 384 * KB, OFF_QHEAD = 416 * MB + 388 * KB, OFF_KN = 416 * MB + 392 * KB, OFF_WSC = 416 * MB + 512 * KB, OFF_WQ8 = OFF_HW, OFF_SSQ2 = 417 * MB, OFF_BAR = 418 * MB;
constexpr size_t WS_NEED = 484 * MB;
static_assert(OFF_SSQ2 + 1 * MB <= WS_NEED, "ws map");

constexpr int LDS_BYTES = 136 * 1024, LDS_ST_OFF = LDS_BYTES - 16;
struct Params {
  const float *x, *attn_g, *w_in, *dlam, *dng, *rld, *rng_, *w_out, *ffn_g, *wq, *keys, *pu, *pv, *fg;
  float* out; char* ws; int coop_sync; int pad_;
};

namespace pg8 {
constexpr int BM = 256, BK = 64, HALF = 128, HTB = HALF * BK * 2, STAGE_BYTES = 8 * HTB, NXCD = 8, WGM = 8;
__host__ __device__ __forceinline__ int lds_byte(int r, int c) { const int st = (r >> 4) * 2 + (c >> 5), rr = r & 15, cc = c & 31, ob = rr * 64 + cc * 2; return st * 1024 + (ob ^ (((ob >> 9) & 1) << 5)); }
__host__ __device__ __forceinline__ void stage_rc(int b, int& R, int& C) { const int st = b / 1024, sb = b % 1024, swz = sb ^ (((sb >> 9) & 1) << 5); R = (st >> 1) * 16 + swz / 64; C = (st & 1) * 32 + (swz % 64) / 2; }
__host__ __device__ __forceinline__ int perm32(int rho) { const int n = rho >> 4, i = rho & 15; return 8 * (i >> 2) + 4 * n + (i & 3); }
struct Unit { int pm, pn; };
struct Gemm { const bf16_t* A; const bf16_t* Bt; int M, N, K; };
struct StaticOrder {
  int nM, nN, nwg, G, c;
  __host__ __device__ void init(int M, int N, int G_, int c_) { nM = M / BM; nN = N / BM; nwg = nM * nN; G = G_; c = c_; }
  __host__ __device__ bool next(int i, Unit& u) const {
    const long L = (long)i * G + c; if (L >= nwg) return false;
    int wgid = (int)L; { const int q = nwg / NXCD, r = nwg % NXCD, xcd = wgid % NXCD, off = wgid / NXCD; wgid = (xcd < r ? xcd * (q + 1) : r * (q + 1) + (xcd - r) * q) + off; }
    const int nig = WGM * nN, gid = wgid / nig, fm = gid * WGM, gsz = (nM - fm) < WGM ? (nM - fm) : WGM;
    u.pm = fm + ((wgid % nig) % gsz); u.pn = (wgid % nig) / gsz; return true;
  }
};
struct BalancedOrder : StaticOrder {
  __host__ __device__ bool next(int i, Unit& u) const { if (!StaticOrder::next(i, u)) return false; u.pn ^= ((u.pm >> 3) & 1) << 1; return true; }
};
template <class Epi, class Order>
__device__ __forceinline__ void gemm_phase(LAS unsigned char* lds, const Gemm g, const Order& S, Epi& E) {
  int tid = threadIdx.x; asm volatile("" : "+v"(tid));
  const int wid = __builtin_amdgcn_readfirstlane(tid >> 6), lane = tid & 63, wr = wid >> 2, wc = wid & 3, fr = lane & 15, fq = lane >> 4;
  const int K = g.K, nt = K / BK;
  unsigned voffA[2], voffB[2];
#pragma unroll
  for (int i = 0; i < 2; ++i) { int R, C; stage_rc(tid * 16 + i * 8192, R, C); const int Rb = Epi::PERM ? ((R & ~31) + perm32(R & 31)) : R;
    voffA[i] = (unsigned)(R * K + C) * 2u; voffB[i] = (unsigned)(Rb * K + C) * 2u; }
  const size_t kstep = (size_t)(BK * 2);
  const size_t hstep = (size_t)HALF * K * 2;
  const size_t tstep = 2 * hstep;
  const unsigned ldsw = (unsigned)wid * 1024u;
  const int aoff = lds_byte(wr * 64 + fr, fq * 8), boff = lds_byte(wc * 32 + fr, fq * 8);
#define PG8_SA(b, h) (((b) * 2 + (h)) * HTB)
#define PG8_SB(b, h) ((4 + (b) * 2 + (h)) * HTB)
#define PG8_STAGE(bufoff, gbase, voff) do { _Pragma("unroll") for (int _i = 0; _i < 2; ++_i) \
    __builtin_amdgcn_global_load_lds((const unsigned*)((const char*)(gbase) + (voff)[_i]), (LAS unsigned*)(lds + (bufoff) + ldsw + _i * 8192), 16, 0, 0); } while (0)
#define PG8_LDA(dst, b, h) do { _Pragma("unroll") for (int m = 0; m < 4; ++m) _Pragma("unroll") for (int k = 0; k < 2; ++k) dst[m][k] = *(const LAS bf16x8*)(lds + PG8_SA(b, h) + aoff + m * 2048 + k * 1024); } while (0)
#define PG8_LDB(dst, b, h) do { _Pragma("unroll") for (int n = 0; n < 2; ++n) _Pragma("unroll") for (int k = 0; k < 2; ++k) dst[n][k] = *(const LAS bf16x8*)(lds + PG8_SB(b, h) + boff + n * 2048 + k * 1024); } while (0)
#define PG8_MMA(ai, bj, At, Bt) do { __builtin_amdgcn_s_setprio(1); _Pragma("unroll") for (int m = 0; m < 4; ++m) _Pragma("unroll") for (int n = 0; n < 2; ++n) _Pragma("unroll") for (int k = 0; k < 2; ++k) \
    acc[ai][bj][m][n] = __builtin_amdgcn_mfma_f32_16x16x32_bf16(Bt[n][k], At[m][k], acc[ai][bj][m][n], 0, 0, 0); __builtin_amdgcn_s_setprio(0); } while (0)
#define PG8_WAIT_V(n) asm volatile("s_waitcnt vmcnt(" #n ")" ::: "memory")
#define PG8_WAIT_L(n) asm volatile("s_waitcnt lgkmcnt(" #n ")" ::: "memory")
#define PG8_BAR __builtin_amdgcn_s_barrier()
#define PG8_SCHED __builtin_amdgcn_sched_barrier(0)
  Unit cur, nxt; int ui = 0;
  if (!S.next(0, cur)) return;
  f32x4 acc[2][2][4][2];
#pragma unroll
  for (int a = 0; a < 2; ++a)
#pragma unroll
    for (int b = 0; b < 2; ++b)
#pragma unroll
      for (int m = 0; m < 4; ++m)
#pragma unroll
        for (int n = 0; n < 2; ++n) acc[a][b][m][n] = (f32x4){0.f, 0.f, 0.f, 0.f};
  bf16x8 At[4][2], B0[2][2], B1[2][2];
  const char* cA = (const char*)g.A + (size_t)cur.pm * tstep; const char* cB = (const char*)g.Bt + (size_t)cur.pn * tstep;
  PG8_STAGE(PG8_SB(0, 0), cB, voffB); PG8_STAGE(PG8_SA(0, 0), cA, voffA); PG8_STAGE(PG8_SB(0, 1), cB + hstep, voffB); PG8_STAGE(PG8_SA(0, 1), cA + hstep, voffA);
  if (wr == 1) PG8_BAR;
  PG8_WAIT_V(4); PG8_BAR;
  PG8_STAGE(PG8_SB(1, 0), cB + kstep, voffB); PG8_STAGE(PG8_SA(1, 0), cA + kstep, voffA); PG8_STAGE(PG8_SB(1, 1), cB + hstep + kstep, voffB);
  PG8_WAIT_V(6); PG8_BAR;
  for (;;) {
    const bool has_next = S.next(ui + 1, nxt);
    E.pre(cur, wr, fr);
    const char* nA = has_next ? (const char*)g.A + (size_t)nxt.pm * tstep : cA; const char* nB = has_next ? (const char*)g.Bt + (size_t)nxt.pn * tstep : cB;
    for (int t = 0; t < nt; t += 2) {
      const bool last = (t == nt - 2);
      const char* a1 = cA + (size_t)(t + 1) * kstep;
      const char* a2 = last ? nA : cA + (size_t)(t + 2) * kstep; const char* b2 = last ? nB : cB + (size_t)(t + 2) * kstep;
      const char* a3 = a2 + kstep; const char* b3 = b2 + kstep;
      PG8_LDB(B0, 0, 0); PG8_SCHED; PG8_LDA(At, 0, 0); PG8_STAGE(PG8_SA(1, 1), a1 + hstep, voffA);
      PG8_WAIT_L(8); PG8_BAR; PG8_WAIT_L(0); PG8_MMA(0, 0, At, B0); PG8_BAR; PG8_SCHED;
      PG8_LDB(B1, 0, 1); PG8_STAGE(PG8_SB(0, 0), b2, voffB);
      PG8_BAR; PG8_WAIT_L(0); PG8_MMA(0, 1, At, B1); PG8_BAR;
      PG8_LDA(At, 0, 1); PG8_STAGE(PG8_SA(0, 0), a2, voffA);
      PG8_BAR; PG8_WAIT_L(0); PG8_MMA(1, 0, At, B0); PG8_BAR; PG8_SCHED;
      PG8_STAGE(PG8_SB(0, 1), b2 + hstep, voffB);
      PG8_WAIT_V(6); PG8_BAR; PG8_MMA(1, 1, At, B1); PG8_BAR;
      PG8_LDB(B0, 1, 0); PG8_SCHED; PG8_LDA(At, 1, 0); PG8_STAGE(PG8_SA(0, 1), a2 + hstep, voffA);
      PG8_WAIT_L(8); PG8_BAR; PG8_WAIT_L(0); PG8_MMA(0, 0, At, B0); PG8_BAR; PG8_SCHED;
      PG8_LDB(B1, 1, 1); PG8_STAGE(PG8_SB(1, 0), b3, voffB);
      PG8_BAR; PG8_WAIT_L(0); PG8_MMA(0, 1, At, B1); PG8_BAR;
      PG8_LDA(At, 1, 1); PG8_STAGE(PG8_SA(1, 0), a3, voffA);
      PG8_BAR; PG8_WAIT_L(0); PG8_MMA(1, 0, At, B0); PG8_BAR; PG8_SCHED;
      PG8_STAGE(PG8_SB(1, 1), b3 + hstep, voffB);
      PG8_WAIT_V(6); PG8_BAR; PG8_MMA(1, 1, At, B1); PG8_BAR;
    }
    E(acc, cur, wr, wc, fr, fq);
    if (!has_next) break;
#pragma unroll
    for (int a = 0; a < 2; ++a)
#pragma unroll
      for (int b = 0; b < 2; ++b)
#pragma unroll
        for (int m = 0; m < 4; ++m)
#pragma unroll
          for (int n = 0; n < 2; ++n) acc[a][b][m][n] = (f32x4){0.f, 0.f, 0.f, 0.f};
    cur = nxt; cA = nA; cB = nB; ++ui;
  }
  PG8_WAIT_V(0);
  if (wr == 0) PG8_BAR;
  PG8_BAR;
#undef PG8_SA
#undef PG8_SB
#undef PG8_STAGE
#undef PG8_LDA
#undef PG8_LDB
#undef PG8_MMA
#undef PG8_WAIT_V
#undef PG8_WAIT_L
#undef PG8_BAR
#undef PG8_SCHED
}
}

__host__ __device__ __forceinline__ int sigma_in(int c) {
  const int pn = c >> 8, t = c & 255, bj = t >> 7, wc = (t >> 5) & 3, u = t & 31;
  if (pn < 4) return pn * 256 + wc * 64 + (u < 8 ? bj * 8 + u : 16 + bj * 24 + (u - 8));
  if (pn == 6 || pn == 7) return pn * 256 + wc * 64 + bj * 32 + u;
  return c;
}
template <bool SIG>
__device__ __forceinline__ void transpose_tile(const float* __restrict__ W, int N, const float* __restrict__ g, bf16_t* __restrict__ Wt, int k0, int n0, float* tile  ) {
  const int tid = otid();
  { const int r = tid >> 4, c4 = (tid & 15) * 4;
    if (SIG) {
#pragma unroll
      for (int i = 0; i < 2; ++i)
#pragma unroll
        for (int jj = 0; jj < 4; ++jj) tile[(r + 32 * i) * 65 + c4 + jj] = W[(size_t)(k0 + r + 32 * i) * N + sigma_in(n0 + c4 + jj)];
    } else {
#pragma unroll
      for (int i = 0; i < 2; ++i) { const float4 v = *(const float4*)(W + (size_t)(k0 + r + 32 * i) * N + n0 + c4); float* tp = tile + (r + 32 * i) * 65 + c4; tp[0] = v.x; tp[1] = v.y; tp[2] = v.z; tp[3] = v.w; }
    } }
  __syncthreads();
  { const int i = tid >> 3, j8 = (tid & 7) * 8; const int sc = i;
    float v[8];
#pragma unroll
    for (int jj = 0; jj < 8; ++jj) v[jj] = tile[(j8 + jj) * 65 + sc] * (g ? g[k0 + j8 + jj] : 1.f);
    u32x4 w; w.x = cvt_pk_bf16(v[0], v[1]); w.y = cvt_pk_bf16(v[2], v[3]); w.z = cvt_pk_bf16(v[4], v[5]); w.w = cvt_pk_bf16(v[6], v[7]);
    *(u32x4*)(Wt + (size_t)(n0 + i) * 1024 + k0 + j8) = w; }
  __syncthreads();
}

__device__ __forceinline__ void phase_prep(const Params& p, char* smem) {
  const int tid = otid(), wid = tid >> 6, lane = tid & 63, nb = gridDim.x, bid = blockIdx.x;
  const int gw = bid * 8 + wid, nw = nb * 8, gt = bid * 512 + tid, ntd = nb * 512;
  char* ws = p.ws;
  { bf16_t* xb = (bf16_t*)(ws + OFF_XB); float* rstd0 = (float*)(ws + OFF_RSTD0);
    struct Rows { float4 v[4][4]; };
    auto ldrows = [&](int row0, Rows& R) {
#pragma unroll
      for (int r = 0; r < 4; ++r) { const float4* xr = (const float4*)(p.x + (size_t)(row0 + r) * 1024);
#pragma unroll
        for (int i = 0; i < 4; ++i) R.v[r][i] = xr[lane + 64 * i]; } };
    auto dorows = [&](int row0, const Rows& R) {
      float ss[4];
#pragma unroll
      for (int r = 0; r < 4; ++r) { float s_ = 0.f;
#pragma unroll
        for (int i = 0; i < 4; ++i) s_ += R.v[r][i].x * R.v[r][i].x + R.v[r][i].y * R.v[r][i].y + R.v[r][i].z * R.v[r][i].z + R.v[r][i].w * R.v[r][i].w;
        ss[r] = wave_sum(s_); }
#pragma unroll
      for (int r = 0; r < 4; ++r) {
#pragma unroll
        for (int i = 0; i < 4; ++i) { u32x2 w; w.x = cvt_pk_bf16(R.v[r][i].x, R.v[r][i].y); w.y = cvt_pk_bf16(R.v[r][i].z, R.v[r][i].w); *(u32x2*)(xb + (size_t)(row0 + r) * 1024 + (lane + 64 * i) * 4) = w; }
        if (lane == 0) rstd0[row0 + r] = rsqrtf(ss[r] * (1.f / 1024.f) + EPS); } };
    Rows RA, RB; const int st4 = nw * 4; int row0 = gw * 4;
    if (row0 < T) ldrows(row0, RA);
    for (; row0 < T; row0 += 2 * st4) {
      if (row0 + st4 < T) ldrows(row0 + st4, RB);
      dorows(row0, RA);
      if (row0 + st4 < T) { if (row0 + 2 * st4 < T) ldrows(row0 + 2 * st4, RA); dorows(row0 + st4, RB); }
    } }
  { float* tile = (float*)smem;
    for (int it = bid; it < 1536; it += nb) {
      if (it < 768) transpose_tile<true>(p.w_in, 3072, p.attn_g, (bf16_t*)(ws + OFF_WIN), (it & 15) * 64, (it >> 4) * 64, tile);
      else if (it < 1024) { const int j = it - 768; transpose_tile<false>(p.w_out, 1024, nullptr, (bf16_t*)(ws + OFF_WOUT), (j & 15) * 64, (j >> 4) * 64, tile); }
      else { const int j = it - 1024; transpose_tile<false>(p.wq, 2048, p.ffn_g, (bf16_t*)(ws + OFF_WQ), (j & 15) * 64, (j >> 4) * 64, tile); }
    } }
  { bf16_t* kb = (bf16_t*)(ws + OFF_KEYS); for (int i = gt; i < 16 * 128 * 128; i += ntd) kb[i] = f2bf(p.keys[i]); }
  if (gw == 0) { const float s1 = wave_sum(p.dlam[lane] * p.dlam[64 + lane]), s2 = wave_sum(p.dlam[128 + lane] * p.dlam[192 + lane]);
    if (lane == 0) *(float*)(ws + OFF_LAM) = expf(s1) - expf(s2) + 0.2f; }
  { float* ssq1 = (float*)(ws + OFF_SSQ1); for (int i = gt; i < T; i += ntd) ssq1[i] = 0.f; if (gt < 64) { ((unsigned*)(ws + OFF_QHEAD))[gt] = 0u; ((unsigned*)(ws + OFF_KN))[gt] = 0u; } }
}

struct EpiInproj {
  static constexpr bool PERM = true;
  char* ws; const float* rstd0; unsigned* kn; float rsv[8];
  __device__ __forceinline__ void pre(const pg8::Unit& u, int wr, int fr) {
    const float* bp = rstd0 + u.pm * 256 + wr * 64 + fr;
#define PG8_RL(i, OFS) asm volatile("global_load_dword %0, %1, off offset:" #OFS : "=v"(rsv[i]) : "v"(bp) : "memory")
    PG8_RL(0, 0); PG8_RL(1, 64); PG8_RL(2, 128); PG8_RL(3, 192); PG8_RL(4, 512); PG8_RL(5, 576); PG8_RL(6, 640); PG8_RL(7, 704);
#undef PG8_RL
  }
  __device__ __forceinline__ static void st8(bf16_t* p, f32x4 a, f32x4 b) { u32x4 w; w.x = cvt_pk_bf16(a[0], a[1]); w.y = cvt_pk_bf16(a[2], a[3]); w.z = cvt_pk_bf16(b[0], b[1]); w.w = cvt_pk_bf16(b[2], b[3]); *(u32x4*)p = w; }
  __device__ __forceinline__ static void rot8(float pos, const float (&cf)[8], f32x4& a0, f32x4& a1, f32x4& b0, f32x4& b1) {
    f32x4 co0, si0, co1, si1;
#pragma unroll
    for (int i = 0; i < 4; ++i) { const float r0 = __builtin_amdgcn_fractf(pos * cf[i]), r1 = __builtin_amdgcn_fractf(pos * cf[4 + i]);
      co0[i] = __builtin_amdgcn_cosf(r0); si0[i] = __builtin_amdgcn_sinf(r0); co1[i] = __builtin_amdgcn_cosf(r1); si1[i] = __builtin_amdgcn_sinf(r1); }
    const f32x4 x0 = a0, x1 = a1, y0 = b0, y1 = b1;
    a0 = x0 * co0 - y0 * si0; a1 = x1 * co1 - y1 * si1; b0 = y0 * co0 + x0 * si0; b1 = y1 * co1 + x1 * si1;
  }
  __device__ __forceinline__ void operator()(const f32x4 (&acc)[2][2][4][2], const pg8::Unit& u, int wr, int wc, int fr, int fq) const {
    const int pn = u.pn;
    float cf[8];
    { const bool retn = pn >= 6; const float l2 = retn ? -13.287712379549449f / 31.f : -18.931568569324174f / 8.f;
      const int f0 = retn ? 8 * fq : 0;
#pragma unroll
      for (int i = 0; i < 8; ++i) cf[i] = __builtin_amdgcn_exp2f(l2 * (float)(f0 + i)) * 0.15915494309189535f; }
    float kmax = 0.f;
#pragma unroll
    for (int ai = 0; ai < 2; ++ai)
#pragma unroll
      for (int m = 0; m < 4; ++m) {
        const int row = u.pm * 256 + ai * 128 + wr * 64 + m * 16 + fr; const float rs = rsv[ai * 4 + m]; const float pos = (float)(row & (S - 1));
        f32x4 a0 = acc[ai][0][m][0] * rs, a1 = acc[ai][0][m][1] * rs, b0 = acc[ai][1][m][0] * rs, b1 = acc[ai][1][m][1] * rs;
        if (pn == 2 || pn == 3) { float ss = 0.f;
#pragma unroll
          for (int e = 0; e < 4; ++e) ss += a0[e] * a0[e] + a1[e] * a1[e] + b0[e] * b0[e] + b1[e] * b1[e];
          ss += __shfl_xor(ss, 16); ss += __shfl_xor(ss, 32); kmax = fmaxf(kmax, ss); }
        if (pn < 4) {
          bf16_t* dst = (bf16_t*)(ws + (pn < 2 ? OFF_QD : OFF_KD)) + (size_t)row * 512 + (pn & 1) * 256 + wc * 64;
          if (fq == 0) { rot8(pos, cf, a0, a1, b0, b1); st8(dst, a0, a1); st8(dst + 8, b0, b1); }
          else { st8(dst + 8 + 8 * fq, a0, a1); st8(dst + 32 + 8 * fq, b0, b1); }
        } else if (pn == 6 || pn == 7) {
          rot8(pos, cf, a0, a1, b0, b1);
          if (pn == 7) { a0 = a0 * 0.125f; a1 = a1 * 0.125f; b0 = b0 * 0.125f; b1 = b1 * 0.125f; }
          bf16_t* dst = (bf16_t*)(ws + (pn == 6 ? OFF_RQ : OFF_RK)) + (size_t)row * 256 + wc * 64;
          st8(dst + 8 * fq, a0, a1); st8(dst + 32 + 8 * fq, b0, b1);
        } else {
          bf16_t* base = (bf16_t*)(ws + (pn < 6 ? OFF_VD : pn < 10 ? OFF_RV : OFF_RG)); const int pb = pn < 6 ? 4 : pn < 10 ? 8 : 10;
          bf16_t* dst = base + (size_t)row * 512 + (pn - pb) * 256 + wc * 32 + 8 * fq;
          st8(dst, a0, a1); st8(dst + 128, b0, b1);
        }
      }
    if (pn == 2 || pn == 3) {
      kmax = wave_max(kmax) * 1.01f;
      if ((fr | fq) == 0) atomicMax(kn + ((u.pm * 256) >> 12) * 8 + (pn & 1) * 4 + wc, __float_as_uint(kmax)); }
  }
};

namespace att {
typedef short s16x4 __attribute__((ext_vector_type(4)));
typedef float f32x16 __attribute__((ext_vector_type(16)));
constexpr int KVBLK = 64, LDQ = 512, LDK = 512;
constexpr float SCALE = 0.125f, SHIFT = 20.f;
constexpr size_t SHM_V = KVBLK * 128 * 2, SHM_K = KVBLK * 128 * 2;
#define KSWZ(row, colB) ((row) * 256 + ((colB) ^ (((row) & 7) << 4)))
#define SBAR() __builtin_amdgcn_sched_barrier(0)
__device__ __forceinline__ int crow(int r, int hi) { return (r & 3) + 8 * (r >> 2) + 4 * hi; }
__device__ __forceinline__ bf16x8 ld8(const bf16_t* p) { return *reinterpret_cast<const bf16x8*>(p); }
__device__ __forceinline__ void partialSM(f32x16& p0, f32x16& p1) {
#pragma unroll
  for (int r = 0; r < 16; ++r) p0[r] = __builtin_amdgcn_exp2f(p0[r]);
}
__device__ __forceinline__ void finishSM(f32x16& p0, f32x16& p1, bf16x8& pa0, bf16x8& pa1, bf16x8& pa2, bf16x8& pa3, f32x2& l0, f32x2& l1) {
#pragma unroll
  for (int r = 0; r < 16; ++r) p1[r] = __builtin_amdgcn_exp2f(p1[r]);
#pragma unroll
  for (int r = 0; r < 16; r += 2) { l0 += (f32x2){p0[r], p0[r + 1]}; l1 += (f32x2){p1[r], p1[r + 1]}; }
#define PK4(P, BASE, OUT) do { u32x4 w = {cvt_pk_bf16(P[BASE + 0], P[BASE + 1]), cvt_pk_bf16(P[BASE + 2], P[BASE + 3]), cvt_pk_bf16(P[BASE + 4], P[BASE + 5]), cvt_pk_bf16(P[BASE + 6], P[BASE + 7])}; \
    OUT = *reinterpret_cast<bf16x8*>(&w); } while (0)
  PK4(p0, 0, pa0); PK4(p0, 8, pa1); PK4(p1, 0, pa2); PK4(p1, 8, pa3);
#undef PK4
}
__device__ __forceinline__ void qkt(f32x16& p0, f32x16& p1, const char* Ks, const bf16x8* qr, int r32, int hi, int map, const f32x16& mCv) {
#pragma unroll
  for (int d0 = 0; d0 < 4; ++d0) { const int cb = ((map * 4 + d0) * 16 + hi * 8) * 2;
    const bf16x8 b0 = *reinterpret_cast<const bf16x8*>(Ks + KSWZ(r32, cb));
    const bf16x8 b1 = *reinterpret_cast<const bf16x8*>(Ks + KSWZ(32 + r32, cb));
    if (d0 == 0) { p0 = __builtin_amdgcn_mfma_f32_32x32x16_bf16(b0, qr[0], mCv, 0, 0, 0); p1 = __builtin_amdgcn_mfma_f32_32x32x16_bf16(b1, qr[0], mCv, 0, 0, 0); }
    else { p0 = __builtin_amdgcn_mfma_f32_32x32x16_bf16(b0, qr[d0], p0, 0, 0, 0); p1 = __builtin_amdgcn_mfma_f32_32x32x16_bf16(b1, qr[d0], p1, 0, 0, 0); } }
}
__device__ __forceinline__ int v_st(int k, int c) { const int kk = (k & ~0xC) | ((k & 4) << 1) | ((k & 8) >> 1); return ((kk >> 3) * 4 + (c >> 5)) * 512 + ((kk & 7) * 32 + (c & 31)) * 2; }
__device__ __forceinline__ int v_stn(int k, int c) { return ((k >> 3) * 4 + (c >> 5)) * 512 + ((k & 7) * 32 + (c & 31)) * 2; }
__device__ __forceinline__ int v_rd_base(int lane) { return ((lane & 3) << 3) | (((lane >> 2) & 3) << 6) | (((lane >> 4) & 1) << 5) | (((lane >> 5) & 1) << 8); }
constexpr int v_rd_off(int d0, int ks, int half) { return d0 * 512 + ks * 4096 + half * 2048; }
template <int OFF> __device__ __forceinline__ s16x4 tr_read(int vb) {
  s16x4 r; asm volatile("ds_read_b64_tr_b16 %0, %1 offset:%2" : "=&v"(r) : "v"(vb), "i"(OFF) : "memory"); return r;
}
template <int D0> __device__ __forceinline__ void pv_one(f32x16& od, int vb, bf16x8 pa0, bf16x8 pa1, bf16x8 pa2, bf16x8 pa3) {
  const s16x4 l0 = tr_read<v_rd_off(D0, 0, 0)>(vb), h0 = tr_read<v_rd_off(D0, 0, 1)>(vb), l1 = tr_read<v_rd_off(D0, 1, 0)>(vb), h1 = tr_read<v_rd_off(D0, 1, 1)>(vb);
  const s16x4 l2 = tr_read<v_rd_off(D0, 2, 0)>(vb), h2 = tr_read<v_rd_off(D0, 2, 1)>(vb), l3 = tr_read<v_rd_off(D0, 3, 0)>(vb), h3 = tr_read<v_rd_off(D0, 3, 1)>(vb);
  asm volatile("s_waitcnt lgkmcnt(0)" ::: "memory"); SBAR();
#define PK(L, H) (bf16x8){L[0], L[1], L[2], L[3], H[0], H[1], H[2], H[3]}
  od = __builtin_amdgcn_mfma_f32_32x32x16_bf16(PK(l0, h0), pa0, od, 0, 0, 0);
  od = __builtin_amdgcn_mfma_f32_32x32x16_bf16(PK(l1, h1), pa1, od, 0, 0, 0);
  od = __builtin_amdgcn_mfma_f32_32x32x16_bf16(PK(l2, h2), pa2, od, 0, 0, 0);
  od = __builtin_amdgcn_mfma_f32_32x32x16_bf16(PK(l3, h3), pa3, od, 0, 0, 0);
#undef PK
}
__device__ __forceinline__ void pv_d0(f32x16* o, int vb, bf16x8 pa0, bf16x8 pa1, bf16x8 pa2, bf16x8 pa3) {
  pv_one<0>(o[0], vb, pa0, pa1, pa2, pa3); pv_one<1>(o[1], vb, pa0, pa1, pa2, pa3); pv_one<2>(o[2], vb, pa0, pa1, pa2, pa3); pv_one<3>(o[3], vb, pa0, pa1, pa2, pa3);
}
__device__ __forceinline__ void attn_item(const bf16_t* __restrict__ Qb, const bf16_t* __restrict__ Kh, const bf16_t* __restrict__ Vh, bf16_t* __restrict__ mixo,
                                          const float* __restrict__ dng, float lam, const float* __restrict__ kn2  , char* lds) {
  const int tid = otid(), wid = tid >> 6, lane = tid & 63, r32 = lane & 31, hi = lane >> 5, qsub = wid >> 1, map = wid & 1;
  char* V_lds = lds; char* K_lds = lds + 4 * SHM_V;
  f32x16 o[4] = {}; f32x2 l0 = {0.f, 0.f}, l1 = {0.f, 0.f}; bf16x8 qr[4];
  const bf16_t* Qw = Qb + (long)(qsub * 32 + r32) * LDQ + map * 64 + hi * 8;
#pragma unroll
  for (int d0 = 0; d0 < 4; ++d0) qr[d0] = ld8(Qw + d0 * 16);
  float mC;
  { float qn = 0.f;
#pragma unroll
    for (int d0 = 0; d0 < 4; ++d0)
#pragma unroll
      for (int e = 0; e < 8; ++e) { const float v = bf2f((bf16_t)qr[d0][e]); qn = fmaf(v, v, qn); }
    { auto rr = __builtin_amdgcn_permlane32_swap(__float_as_uint(qn), __float_as_uint(qn), false, false); qn = __uint_as_float(rr[0]) + __uint_as_float(rr[1]); }
    mC = -(SCALE * sqrtf(qn * kn2[map]) * 1.0001f - SHIFT) * 1.4426950408889634f; }
  { constexpr float C = SCALE * 1.4426950408889634f;
#pragma unroll
    for (int d0 = 0; d0 < 4; ++d0) { u32x4 w;
#pragma unroll
      for (int e = 0; e < 4; ++e) w[e] = cvt_pk_bf16(bf2f((bf16_t)qr[d0][2 * e]) * C, bf2f((bf16_t)qr[d0][2 * e + 1]) * C);
      qr[d0] = *reinterpret_cast<bf16x8*>(&w); } }
  f32x16 mCv;
#pragma unroll
  for (int r = 0; r < 16; ++r) mCv[r] = mC;
  const int vb0 = (int)(uintptr_t)V_lds + v_rd_base(lane);
  const int widu = __builtin_amdgcn_readfirstlane(wid);
  unsigned goV[2], goK[2];
#pragma unroll
  for (int i = 0; i < 2; ++i) { const int q = 2 * widu + i;
    const int keyV = 8 * (q >> 1) + ((lane & 31) >> 2), colV = 32 * (2 * (q & 1) + (lane >> 5)) + (lane & 3) * 8;
    goV[i] = (unsigned)(keyV * LDK + colV) * 2u;
    const int rowK = 4 * q + (lane >> 4), cbp = (lane & 15) * 16;
    goK[i] = (unsigned)(rowK * LDK * 2 + (cbp ^ ((rowK & 7) << 4))); }
  LAS char* ldsL = (LAS char*)lds + 2048 * widu;
#define DMA(slot, k0) do { const char* gv_ = (const char*)Vh + (size_t)(k0) * (LDK * 2); const char* gk_ = (const char*)Kh + (size_t)(k0) * (LDK * 2); \
    _Pragma("unroll") for (int i_ = 0; i_ < 2; ++i_) { \
      __builtin_amdgcn_global_load_lds((const unsigned*)(gv_ + goV[i_]), (LAS unsigned*)(ldsL + (slot) * (int)SHM_V + i_ * 1024), 16, 0, 0); \
      __builtin_amdgcn_global_load_lds((const unsigned*)(gk_ + goK[i_]), (LAS unsigned*)(ldsL + 4 * (int)SHM_V + (slot) * (int)SHM_K + i_ * 1024), 16, 0, 0); } } while (0)
#define BARV(n) do { asm volatile("s_waitcnt vmcnt(" #n ") lgkmcnt(0)" ::: "memory"); __builtin_amdgcn_s_barrier(); asm volatile("" ::: "memory"); } while (0)
  f32x16 pA0, pA1, pB0, pB1; bf16x8 pa0, pa1, pa2, pa3; constexpr int NT = S / KVBLK;
#define STEP(jj, RG, PC0, PC1, PP0, PP1) do {     \
    constexpr int rcur = (RG) * (int)SHM_K, rprv = (((RG) + 3) & 3) * (int)SHM_V; \
    SBAR(); qkt(PC0, PC1, K_lds + rcur, qr, r32, hi, map, mCv); \
    finishSM(PP0, PP1, pa0, pa1, pa2, pa3, l0, l1); SBAR(); \
    if ((jj) + 2 < NT) DMA(((RG) + 2) & 3, ((jj) + 2) * KVBLK); SBAR(); \
    pv_d0(o, vb0 + rprv, pa0, pa1, pa2, pa3); partialSM(PC0, PC1); \
    if ((jj) + 2 < NT) BARV(4); else BARV(0); } while (0)
  DMA(0, 0); DMA(1, KVBLK); BARV(4);
  qkt(pA0, pA1, K_lds, qr, r32, hi, map, mCv); partialSM(pA0, pA1);
  DMA(2, 2 * KVBLK); BARV(4);
  static_assert(NT % 4 == 0, "ring constants below assume NT % 4 == 0");
  for (int j = 1; j + 3 < NT; j += 4) {
    STEP(j, 1, pB0, pB1, pA0, pA1); STEP(j + 1, 2, pA0, pA1, pB0, pB1); STEP(j + 2, 3, pB0, pB1, pA0, pA1); STEP(j + 3, 0, pA0, pA1, pB0, pB1);
  }
  STEP(NT - 3, 1, pB0, pB1, pA0, pA1); STEP(NT - 2, 2, pA0, pA1, pB0, pB1); STEP(NT - 1, 3, pB0, pB1, pA0, pA1);
  finishSM(pB0, pB1, pa0, pa1, pa2, pa3, l0, l1); SBAR();
  pv_d0(o, vb0 + ((NT - 1) & 3) * (int)SHM_V, pa0, pa1, pa2, pa3);
#undef STEP
#undef DMA
#undef BARV
  float lsum = (l0.x + l0.y) + (l1.x + l1.y);
  { auto rr = __builtin_amdgcn_permlane32_swap(__float_as_uint(lsum), __float_as_uint(lsum), false, false); lsum = __uint_as_float(rr[0]) + __uint_as_float(rr[1]); }
  const float rli = lsum > 0.f ? __builtin_amdgcn_rcpf(lsum) : 0.f;
  __syncthreads();
  float* X = (float*)lds + qsub * 4096;
  if (map == 1) { const float f = rli * lam;
#pragma unroll
    for (int d0 = 0; d0 < 4; ++d0)
#pragma unroll
      for (int r = 0; r < 16; ++r) X[(d0 * 16 + r) * 64 + lane] = o[d0][r] * f;
  }
  __syncthreads();
  if (map == 0) {
    float ss = 0.f;
#pragma unroll
    for (int d0 = 0; d0 < 4; ++d0)
#pragma unroll
      for (int r = 0; r < 16; ++r) { const float v = o[d0][r] * rli - X[(d0 * 16 + r) * 64 + lane]; o[d0][r] = v; ss = fmaf(v, v, ss); }
    { auto rr = __builtin_amdgcn_permlane32_swap(__float_as_uint(ss), __float_as_uint(ss), false, false); ss = __uint_as_float(rr[0]) + __uint_as_float(rr[1]); }
    const float rs = rsqrtf(ss * (1.f / 128.f) + EPS) * 0.8f;
    bf16_t* rowp = mixo + (long)(qsub * 32 + r32) * 1024 + (hi ? 8 : 0);
#pragma unroll
    for (int d0 = 0; d0 < 4; ++d0)
#pragma unroll
      for (int kp = 0; kp < 2; ++kp) {
        const int k = d0 * 4 + 2 * kp;
        const f32x4 ga = *(const f32x4*)(dng + 8 * k + 4 * hi), gb = *(const f32x4*)(dng + 8 * (k + 1) + 4 * hi);
        unsigned ax = cvt_pk_bf16(o[d0][8 * kp + 0] * rs * ga[0], o[d0][8 * kp + 1] * rs * ga[1]), ay = cvt_pk_bf16(o[d0][8 * kp + 2] * rs * ga[2], o[d0][8 * kp + 3] * rs * ga[3]);
        unsigned bx = cvt_pk_bf16(o[d0][8 * kp + 4] * rs * gb[0], o[d0][8 * kp + 5] * rs * gb[1]), by = cvt_pk_bf16(o[d0][8 * kp + 6] * rs * gb[2], o[d0][8 * kp + 7] * rs * gb[3]);
        { auto r0 = __builtin_amdgcn_permlane32_swap(ax, bx, false, false); ax = r0[0]; bx = r0[1]; }
        { auto r1 = __builtin_amdgcn_permlane32_swap(ay, by, false, false); ay = r1[0]; by = r1[1]; }
        *(u32x4*)(rowp + 8 * k) = (u32x4){ax, ay, bx, by};
      }
  }
  __syncthreads();
}
}

__device__ __forceinline__ void phase_attn(const Params& p, char* lds) {
  const float lam = *(const float*)(p.ws + OFF_LAM);
  const bf16_t* Qd = (const bf16_t*)(p.ws + OFF_QD); const bf16_t* Kd = (const bf16_t*)(p.ws + OFF_KD); const bf16_t* Vd = (const bf16_t*)(p.ws + OFF_VD);
  bf16_t* mix = (bf16_t*)(p.ws + OFF_MIX);
  for (int u = blockIdx.x; u < 1024; u += gridDim.x) {
    const int xcd = u & 7, j = u >> 3, bh = (j >> 5) * 8 + xcd, qblk = j & 31, b = bh >> 2, h = bh & 3;
    const size_t t0 = (size_t)b * S;
    att::attn_item(Qd + (t0 + qblk * 128) * 512 + h * 128, Kd + t0 * 512 + h * 128, Vd + t0 * 512 + h * 128, mix + (t0 + qblk * 128) * 1024 + h * 128, p.dng, lam, (const float*)(p.ws + OFF_KN) + bh * 2, lds);
  }
}


namespace ret {
using att::f32x16; using att::s16x4; using att::crow; using att::v_st; using att::v_rd_base; using att::v_rd_off; using att::tr_read; using att::ld8;
constexpr float LOG2E = 1.4426950408889634f;
#define RKL(row, colB) ((row) * 128 + ((colB) ^ (((row) & 7) << 4)))
#define PKF(L, H) (bf16x8){L[0], L[1], L[2], L[3], H[0], H[1], H[2], H[3]}
__device__ __forceinline__ void stage_v(const bf16_t* __restrict__ Rv, size_t t0, int h, char* Vl) {
  const int tid = otid();
#pragma unroll
  for (int i = 0; i < 4; ++i) { const int q = tid + 512 * i, row = q >> 4, c8 = (q & 15) * 8;
    const bf16x8 v = ld8(Rv + (t0 + row) * 512 + h * 128 + c8);
    *(bf16x8*)(Vl + (row >> 6) * 16384 + v_st(row & 63, c8)) = v; }
}
struct TabRows { u32x4 v[4][4]; };
__device__ __forceinline__ void tab_fetch(const Params& p, int r0, int lane, TabRows& tr) {
  const float* src = (r0 < 16384 ? p.pu : p.pv) + (size_t)(r0 & 16383) * 1024 + lane * 16;
#pragma unroll
  for (int k = 0; k < 4; ++k)
#pragma unroll
    for (int i = 0; i < 4; ++i) asm volatile("global_load_dwordx4 %0, %1, off" : "=v"(tr.v[k][i]) : "v"(src + k * 1024 + 4 * i) : "memory");
}
__device__ __forceinline__ void tab_finish(const Params& p, int r0, int lane, const TabRows& tr) {
  unsigned char* U8 = (unsigned char*)(p.ws + OFF_U8); unsigned char* V8 = (unsigned char*)(p.ws + OFF_V8); float* sc = (float*)(p.ws + OFF_USC);
  const bool isU = r0 < 16384;
  float gv[16];
#pragma unroll
  for (int i = 0; i < 16; ++i) gv[i] = 1.f;
  if (isU) {
#pragma unroll
    for (int i = 0; i < 4; ++i) { const float4 g4 = *(const float4*)(p.ffn_g + lane * 16 + 4 * i); gv[4 * i] = g4.x; gv[4 * i + 1] = g4.y; gv[4 * i + 2] = g4.z; gv[4 * i + 3] = g4.w; } }
#pragma unroll
  for (int k = 0; k < 4; ++k) { const int r = r0 + k, e = r & 16383; float v[16];
#pragma unroll
    for (int i = 0; i < 16; ++i) v[i] = __uint_as_float(tr.v[k][i >> 2][i & 3]) * gv[i];
    float am = 0.f;
#pragma unroll
    for (int i = 0; i < 16; ++i) am = fmaxf(am, fabsf(v[i]));
    am = wave_max(am);
    const float scl = am > 0.f ? 127.f / am : 1.f;
    u32x4 w;
#pragma unroll
    for (int i = 0; i < 4; ++i) { const int q0 = __float2int_rn(v[4 * i] * scl), q1 = __float2int_rn(v[4 * i + 1] * scl), q2 = __float2int_rn(v[4 * i + 2] * scl), q3 = __float2int_rn(v[4 * i + 3] * scl);
      w[i] = (unsigned)(q0 & 255) | ((unsigned)(q1 & 255) << 8) | ((unsigned)(q2 & 255) << 16) | ((unsigned)q3 << 24); }
    *(u32x4*)((isU ? U8 : V8) + (size_t)(lane >> 3) * (16384 * 128) + (size_t)e * 128 + (lane & 7) * 16) = w;
    if (lane == 0) sc[r] = am > 0.f ? am * (1.f / 127.f) : 1.f; }
}
struct StIn { bf16x8 v[4], k[2]; };
__device__ __forceinline__ void state_fetch(const Params& p, int item, int tid, StIn& in) {
  const int c = item & 31, bh = item >> 5, h = bh & 3, b = bh >> 2; const size_t t0 = (size_t)b * S + c * 128;
  const bf16_t* Rk = (const bf16_t*)(p.ws + OFF_RK); const bf16_t* Rv = (const bf16_t*)(p.ws + OFF_RV);
#pragma unroll
  for (int i = 0; i < 4; ++i) { const int q = tid + 512 * i, row = q >> 4, c8 = (q & 15) * 8; in.v[i] = ld8(Rv + (t0 + row) * 512 + h * 128 + c8); }
#pragma unroll
  for (int i = 0; i < 2; ++i) { const int q = tid + 512 * i, row = q >> 3, c8 = (q & 7) * 8; in.k[i] = ld8(Rk + (t0 + row) * 256 + h * 64 + c8); }
}
__device__ __forceinline__ void phase_states(const Params& p, char* lds) {
  const int tid = otid(), wid = tid >> 6, lane = tid & 63, r32 = lane & 31, hi = lane >> 5;
  char* Vl = lds; char* Kl = lds + 32768;
  StIn in;
  if ((int)blockIdx.x < 1024) state_fetch(p, blockIdx.x, tid, in);
  for (int item = blockIdx.x; item < 1024; item += gridDim.x) {
    const int h = (item >> 5) & 3;
    const float lgf2 = -expf(p.rld[h]) * LOG2E, lgb2 = -expf(p.rld[4 + h]) * LOG2E;
#pragma unroll
    for (int i = 0; i < 4; ++i) { const int q = tid + 512 * i, row = q >> 4, c8 = (q & 15) * 8; *(bf16x8*)(Vl + (row >> 6) * 16384 + v_st(row & 63, c8)) = in.v[i]; }
#pragma unroll
    for (int i = 0; i < 2; ++i) { const int q = tid + 512 * i, row = q >> 3, c8 = (q & 7) * 8; const bf16x8 kv = in.k[i];
      const float df = __builtin_amdgcn_exp2f(lgf2 * (float)(127 - row)), db = __builtin_amdgcn_exp2f(lgb2 * (float)row);
      float f[8];
#pragma unroll
      for (int e = 0; e < 8; ++e) f[e] = bf2f((bf16_t)kv[e]);
      u32x4 wf, wb;
#pragma unroll
      for (int e = 0; e < 4; ++e) { wf[e] = cvt_pk_bf16(f[2 * e] * df, f[2 * e + 1] * df); wb[e] = cvt_pk_bf16(f[2 * e] * db, f[2 * e + 1] * db); }
      char* kt = Kl + (row >> 6) * 16384;
      *(u32x4*)(kt + v_st(row & 63, c8)) = wf; *(u32x4*)(kt + v_st(row & 63, 64 + c8)) = wb; }
    __syncthreads();
    TabRows tr; const int trow = (item * 8 + wid) * 4; tab_fetch(p, trow, lane, tr);
    if (item + (int)gridDim.x < 1024) state_fetch(p, item + gridDim.x, tid, in);
    const int d0a = wid >> 1;
    const int vbV = (int)(uintptr_t)Vl + v_rd_base(lane), vbK = (int)(uintptr_t)Kl + v_rd_base(lane);
    f32x16 acc[2] = {};
#pragma unroll
    for (int tt = 0; tt < 2; ++tt) {
#define ST_STEP(KS) do { \
      const s16x4 kl = tr_read<v_rd_off(0, KS, 0)>(vbK + tt * 16384 + d0a * 512), kh = tr_read<v_rd_off(0, KS, 1)>(vbK + tt * 16384 + d0a * 512); \
      const s16x4 a0l = tr_read<v_rd_off(0, KS, 0)>(vbV + tt * 16384 + ((wid & 1) * 2) * 512), a0h = tr_read<v_rd_off(0, KS, 1)>(vbV + tt * 16384 + ((wid & 1) * 2) * 512); \
      const s16x4 a1l = tr_read<v_rd_off(1, KS, 0)>(vbV + tt * 16384 + ((wid & 1) * 2) * 512), a1h = tr_read<v_rd_off(1, KS, 1)>(vbV + tt * 16384 + ((wid & 1) * 2) * 512); \
      asm volatile("s_waitcnt lgkmcnt(0)" ::: "memory"); __builtin_amdgcn_sched_barrier(0); \
      acc[0] = __builtin_amdgcn_mfma_f32_32x32x16_bf16(PKF(a0l, a0h), PKF(kl, kh), acc[0], 0, 0, 0); \
      acc[1] = __builtin_amdgcn_mfma_f32_32x32x16_bf16(PKF(a1l, a1h), PKF(kl, kh), acc[1], 0, 0, 0); } while (0)
      ST_STEP(0); ST_STEP(1); ST_STEP(2); ST_STEP(3);
#undef ST_STEP
    }
    asm volatile("s_waitcnt vmcnt(0)" : "+v"(tr.v[0][0]), "+v"(tr.v[0][1]), "+v"(tr.v[0][2]), "+v"(tr.v[0][3]), "+v"(tr.v[1][0]), "+v"(tr.v[1][1]), "+v"(tr.v[1][2]), "+v"(tr.v[1][3]),
                 "+v"(tr.v[2][0]), "+v"(tr.v[2][1]), "+v"(tr.v[2][2]), "+v"(tr.v[2][3]), "+v"(tr.v[3][0]), "+v"(tr.v[3][1]), "+v"(tr.v[3][2]), "+v"(tr.v[3][3]) :: "memory");
    tab_finish(p, trow, lane, tr);
    bf16_t* Kst = (bf16_t*)(p.ws + OFF_ST) + ((size_t)item * 2 + (d0a >> 1)) * 8192;
#pragma unroll
    for (int e = 0; e < 2; ++e)
#pragma unroll
      for (int r = 0; r < 16; ++r) Kst[(((wid & 1) * 2 + e) * 32 + crow(r, hi)) * 64 + (d0a & 1) * 32 + r32] = (bf16_t)(cvt_pk_bf16(acc[e][r], acc[e][r]) & 0xffffu);
    __syncthreads();
  }
}
__device__ __forceinline__ void phase_scan(const Params& p) {
  const bf16_t* __restrict__ Kst = (const bf16_t*)(p.ws + OFF_ST); bf16_t* __restrict__ Sst = (bf16_t*)(p.ws + OFF_SST);
  for (int g = blockIdx.x * 512 + otid(); g < 32 * 2 * 8192; g += gridDim.x * 512) {
    const int e = g & 8191, dir = (g >> 13) & 1, bh = g >> 14, h = bh & 3;
    const float gC = __builtin_amdgcn_exp2f(-expf(p.rld[dir * 4 + h]) * LOG2E * 128.f);
    const size_t base = ((size_t)bh * 32 * 2 + dir) * 8192 + e;
    const long step = dir ? -16384 : 16384; const size_t first = dir ? base + 31 * 16384 : base;
    float k[32];
#pragma unroll
    for (int cc = 0; cc < 32; ++cc) k[cc] = bf2f(Kst[first + (long)cc * step]);
    float s = 0.f;
#pragma unroll
    for (int cc = 0; cc < 32; ++cc) { Sst[first + (long)cc * step] = f2bf(s); s = fmaf(gC, s, k[cc]); }
  }
}
struct OutIn { bf16x8 v[4], k[2], g[4]; };
__device__ __forceinline__ void out_fetch(const Params& p, int item, int tid, OutIn& in) {
  const int c = item & 31, bh = item >> 5, h = bh & 3, b = bh >> 2; const size_t t0 = (size_t)b * S + c * 128;
  const bf16_t* Rk = (const bf16_t*)(p.ws + OFF_RK); const bf16_t* Rv = (const bf16_t*)(p.ws + OFF_RV); const bf16_t* Rg = (const bf16_t*)(p.ws + OFF_RG);
#pragma unroll
  for (int i = 0; i < 4; ++i) { const int q = tid + 512 * i, row = q >> 4, c8 = (q & 15) * 8; in.v[i] = ld8(Rv + (t0 + row) * 512 + h * 128 + c8); in.g[i] = ld8(Rg + (t0 + row) * 512 + h * 128 + c8); }
#pragma unroll
  for (int i = 0; i < 2; ++i) { const int q = tid + 512 * i, row = q >> 3, c8 = (q & 7) * 8; in.k[i] = ld8(Rk + (t0 + row) * 256 + h * 64 + c8); }
}
__device__ __forceinline__ void phase_retout(const Params& p, char* lds) {
  const int tid = otid(), wid = tid >> 6, qsub = wid & 3, dvh = wid >> 2;
  const bf16_t* Rq = (const bf16_t*)(p.ws + OFF_RQ); bf16_t* mix = (bf16_t*)(p.ws + OFF_MIX);
  char* Vl = lds; char* Kl = lds + 32768; char* Gl = lds + 49152; float* St = (float*)(lds + 86016);
  float* Gn = St + 1024;
  { const int t_ = tid; Gn[t_] = p.rng_[t_]; }
  float* Dt = St + 512;
  char* SFl = lds + 92160;
  const int widu = __builtin_amdgcn_readfirstlane(wid);
#define RO_DMA_SF(it_, ln_) do { const char* gs_ = (const char*)((const bf16_t*)(p.ws + OFF_SST) + (size_t)(it_) * 2 * 8192); \
    _Pragma("unroll") for (int i_ = 0; i_ < 4; ++i_) { const int g_ = 4 * widu + i_; \
      __builtin_amdgcn_global_load_lds((const unsigned*)(gs_ + (unsigned)(g_ * 1024 + ((ln_) >> 3) * 128 + ((((ln_) & 7) ^ ((ln_) >> 3)) << 4))), (LAS unsigned*)((LAS char*)lds + 92160 + g_ * 1024), 16, 0, 0); } } while (0)
  { int ln0 = tid & 63; asm volatile("" : "+v"(ln0)); if ((int)blockIdx.x < 1024) RO_DMA_SF((int)blockIdx.x, ln0); }
  OutIn in; int hcur = -1;
  if ((int)blockIdx.x < 1024) out_fetch(p, blockIdx.x, tid, in);
  for (int item = blockIdx.x; item < 1024; item += gridDim.x) {
    int lane = tid & 63; asm volatile("" : "+v"(lane));
    const int r32 = lane & 31, hi = lane >> 5;
    const int c = item & 31, bh = item >> 5, h = bh & 3, b = bh >> 2; const size_t t0 = (size_t)b * S + c * 128;
    if (h != hcur) {
      hcur = h; const float lgf2 = -expf(p.rld[h]) * LOG2E, lgb2 = -expf(p.rld[4 + h]) * LOG2E;
      if (tid < 255) { const int d = tid - 127; Dt[tid] = __builtin_amdgcn_exp2f(d >= 0 ? lgf2 * (float)d : lgb2 * (float)(-d)); }
      else if (tid >= 256 && tid < 384) Dt[tid] = __builtin_amdgcn_exp2f(lgf2 * (float)(tid - 256 + 1));
      else if (tid >= 384) Dt[tid] = __builtin_amdgcn_exp2f(lgb2 * (float)(128 - (tid - 384))); }
    bf16x8 qr[4];
    { const bf16_t* Qw = Rq + (t0 + qsub * 32 + r32) * 256 + h * 64 + hi * 8;
#pragma unroll
      for (int d0 = 0; d0 < 4; ++d0) qr[d0] = ld8(Qw + d0 * 16); }
#pragma unroll
    for (int i = 0; i < 4; ++i) { const int q = tid + 512 * i, row = q >> 4, c8 = (q & 15) * 8;
      *(bf16x8*)(Vl + (row >> 6) * 16384 + att::v_stn(row & 63, c8)) = in.v[i]; *(bf16x8*)(Gl + row * 272 + c8 * 2) = in.g[i]; }
#pragma unroll
    for (int i = 0; i < 2; ++i) { const int q = tid + 512 * i, row = q >> 3, c8 = (q & 7) * 8; *(bf16x8*)(Kl + (row >> 6) * 8192 + RKL(row & 63, c8 * 2)) = in.k[i]; }
    asm volatile("s_waitcnt vmcnt(0)" ::: "memory"); __syncthreads();
    { const int nx = item + (int)gridDim.x; out_fetch(p, nx < 1024 ? nx : item, tid, in); }
    f32x16 o[2];
#pragma unroll
    for (int dir = 0; dir < 2; ++dir) {
      const float qd = Dt[256 + dir * 128 + qsub * 32 + r32];
#pragma unroll
      for (int j = 0; j < 2; ++j) { f32x16 tc = {};
#pragma unroll
        for (int ks = 0; ks < 4; ++ks) { const int srow = (dvh * 2 + j) * 32 + r32;
          const bf16x8 sfr = *reinterpret_cast<const bf16x8*>(SFl + dir * 16384 + srow * 128 + (((ks * 2 + hi) ^ (srow & 7)) << 4));
          tc = __builtin_amdgcn_mfma_f32_32x32x16_bf16(sfr, qr[ks], tc, 0, 0, 0); }
#pragma unroll
        for (int r = 0; r < 16; ++r) o[j][r] = dir == 0 ? qd * tc[r] : fmaf(qd, tc[r], o[j][r]); }
      __builtin_amdgcn_sched_barrier(0);
    }
    f32x16 pq[2][2];
#pragma unroll
    for (int half = 0; half < 2; ++half) {
      f32x16 p0 = {}, p1 = {};
      const char* Ks = Kl + half * 8192;
#pragma unroll
      for (int d0 = 0; d0 < 4; ++d0) { const int cb = (d0 * 16 + hi * 8) * 2;
        const bf16x8 b0 = *reinterpret_cast<const bf16x8*>(Ks + RKL(r32, cb));
        const bf16x8 b1 = *reinterpret_cast<const bf16x8*>(Ks + RKL(32 + r32, cb));
        p0 = __builtin_amdgcn_mfma_f32_32x32x16_bf16(b0, qr[d0], p0, 0, 0, 0);
        p1 = __builtin_amdgcn_mfma_f32_32x32x16_bf16(b1, qr[d0], p1, 0, 0, 0); }
      pq[half][0] = p0; pq[half][1] = p1; }
    bf16x8 pa[2][4];
#pragma unroll
    for (int half = 0; half < 2; ++half) {
      const int i = qsub * 32 + r32;
#pragma unroll
      for (int r = 0; r < 16; ++r) { const int j0 = half * 64 + crow(r, hi);
        pq[half][0][r] *= Dt[127 + i - j0]; pq[half][1][r] *= Dt[127 + i - j0 - 32]; }
#define PK4(P, BASE, OUT) do { u32x4 w = {cvt_pk_bf16(P[BASE + 0], P[BASE + 1]), cvt_pk_bf16(P[BASE + 2], P[BASE + 3]), cvt_pk_bf16(P[BASE + 4], P[BASE + 5]), cvt_pk_bf16(P[BASE + 6], P[BASE + 7])}; \
    OUT = *reinterpret_cast<bf16x8*>(&w); } while (0)
      PK4(pq[half][0], 0, pa[half][0]); PK4(pq[half][0], 8, pa[half][1]); PK4(pq[half][1], 0, pa[half][2]); PK4(pq[half][1], 8, pa[half][3]);
#undef PK4
    }
#pragma unroll
    for (int half = 0; half < 2; ++half) {
      const int vb = (int)(uintptr_t)Vl + half * 16384 + v_rd_base(lane);
      if (dvh == 0) { att::pv_one<0>(o[0], vb, pa[half][0], pa[half][1], pa[half][2], pa[half][3]); att::pv_one<1>(o[1], vb, pa[half][0], pa[half][1], pa[half][2], pa[half][3]); }
      else          { att::pv_one<2>(o[0], vb, pa[half][0], pa[half][1], pa[half][2], pa[half][3]); att::pv_one<3>(o[1], vb, pa[half][0], pa[half][1], pa[half][2], pa[half][3]); }
    }
    __builtin_amdgcn_sched_barrier(0);
    float s1 = 0.f, s2 = 0.f;
#pragma unroll
    for (int j = 0; j < 2; ++j)
#pragma unroll
      for (int r = 0; r < 16; ++r) { s1 += o[j][r]; s2 = fmaf(o[j][r], o[j][r], s2); }
    { auto ra = __builtin_amdgcn_permlane32_swap(__float_as_uint(s1), __float_as_uint(s1), false, false); s1 = __uint_as_float(ra[0]) + __uint_as_float(ra[1]);
      auto rb = __builtin_amdgcn_permlane32_swap(__float_as_uint(s2), __float_as_uint(s2), false, false); s2 = __uint_as_float(rb[0]) + __uint_as_float(rb[1]); }
    if (hi == 0) *(f32x2*)(St + (wid * 32 + r32) * 2) = (f32x2){s1, s2};
    __syncthreads();
    __builtin_amdgcn_sched_barrier(0);
    if (item + (int)gridDim.x < 1024) RO_DMA_SF(item + (int)gridDim.x, lane);
    { const f32x2 ot = *(const f32x2*)(St + ((wid ^ 4) * 32 + r32) * 2);
      const float mu = (s1 + ot.x) * (1.f / 128.f), var = (s2 + ot.y) * (1.f / 128.f) - mu * mu; const float rs = rsqrtf(fmaxf(var, 0.f) + EPS);
      const int row = qsub * 32 + r32;
      bf16_t* rowp = mix + (t0 + row) * 1024 + 512 + h * 128 + dvh * 64 + (hi ? 8 : 0);
      const char* grow = Gl + row * 272 + (dvh * 64 + 4 * hi) * 2;
      const float* gn = Gn + h * 128 + dvh * 64 + 4 * hi;
#pragma unroll
      for (int j = 0; j < 2; ++j)
#pragma unroll
        for (int kp = 0; kp < 2; ++kp) {
          const int k = j * 4 + 2 * kp; unsigned pk[4];
#pragma unroll
          for (int g2 = 0; g2 < 2; ++g2) { const u32x2 gw = *(const u32x2*)(grow + (k + g2) * 16); const f32x4 gv = *(const f32x4*)(gn + 8 * (k + g2));
            const float gt[4] = {__uint_as_float(gw.x << 16), __uint_as_float(gw.x & 0xffff0000u), __uint_as_float(gw.y << 16), __uint_as_float(gw.y & 0xffff0000u)};
            float ov[4];
#pragma unroll
            for (int e = 0; e < 4; ++e) { const float sg = gt[e] * __builtin_amdgcn_rcpf(1.f + __expf(-gt[e])); ov[e] = sg * (o[j][8 * kp + 4 * g2 + e] - mu) * rs * gv[e]; }
            pk[2 * g2] = cvt_pk_bf16(ov[0], ov[1]); pk[2 * g2 + 1] = cvt_pk_bf16(ov[2], ov[3]); }
          { auto r0 = __builtin_amdgcn_permlane32_swap(pk[0], pk[2], false, false); pk[0] = r0[0]; pk[2] = r0[1]; }
          { auto r1 = __builtin_amdgcn_permlane32_swap(pk[1], pk[3], false, false); pk[1] = r1[0]; pk[3] = r1[1]; }
          *(u32x4*)(rowp + 8 * k) = (u32x4){pk[0], pk[1], pk[2], pk[3]};
        } }
    asm volatile("s_waitcnt lgkmcnt(0)" ::: "memory"); __builtin_amdgcn_s_barrier(); asm volatile("" ::: "memory");
  }
}
#undef RO_DMA_SF
}


struct EpiOutproj {
  static constexpr bool PERM = true;
  const bf16_t* xb; bf16_t* x1b; float* ssq;
  __device__ __forceinline__ void pre(const pg8::Unit&, int, int) {}
  __device__ __forceinline__ void operator()(const f32x4 (&acc)[2][2][4][2], const pg8::Unit& u, int wr, int wc, int fr, int fq) const {
#pragma unroll
    for (int ai = 0; ai < 2; ++ai) {
      u32x4 xv[4][2];
#pragma unroll
      for (int m = 0; m < 4; ++m)
#pragma unroll
        for (int bj = 0; bj < 2; ++bj) xv[m][bj] = *(const u32x4*)(xb + (size_t)(u.pm * 256 + ai * 128 + wr * 64 + m * 16 + fr) * 1024 + u.pn * 256 + bj * 128 + wc * 32 + 8 * fq);
      __builtin_amdgcn_sched_barrier(0);
#pragma unroll
      for (int m = 0; m < 4; ++m) {
        const int row = u.pm * 256 + ai * 128 + wr * 64 + m * 16 + fr; float ss = 0.f;
#pragma unroll
        for (int bj = 0; bj < 2; ++bj) {
          const size_t off = (size_t)row * 1024 + u.pn * 256 + bj * 128 + wc * 32 + 8 * fq;
          const u32x4 xw = xv[m][bj];
          const f32x4 v0 = (f32x4){__uint_as_float(xw.x << 16), __uint_as_float(xw.x & 0xffff0000u), __uint_as_float(xw.y << 16), __uint_as_float(xw.y & 0xffff0000u)} + acc[ai][bj][m][0];
          const f32x4 v1 = (f32x4){__uint_as_float(xw.z << 16), __uint_as_float(xw.z & 0xffff0000u), __uint_as_float(xw.w << 16), __uint_as_float(xw.w & 0xffff0000u)} + acc[ai][bj][m][1];
          u32x4 w; w.x = cvt_pk_bf16(v0[0], v0[1]); w.y = cvt_pk_bf16(v0[2], v0[3]); w.z = cvt_pk_bf16(v1[0], v1[1]); w.w = cvt_pk_bf16(v1[2], v1[3]); *(u32x4*)(x1b + off) = w;
          ss += v0[0] * v0[0] + v0[1] * v0[1] + v0[2] * v0[2] + v0[3] * v0[3] + v1[0] * v1[0] + v1[1] * v1[1] + v1[2] * v1[2] + v1[3] * v1[3];
        }
        ss += __shfl_xor(ss, 16); ss += __shfl_xor(ss, 32);
        if (fq == 0) unsafeAtomicAdd(ssq + row, ss);
      }
      __builtin_amdgcn_sched_barrier(0);
    }
  }
};
struct EpiQ {
  static constexpr bool PERM = true;
  const float* ssq; bf16_t* q; float rsv[8];
  __device__ __forceinline__ void pre(const pg8::Unit& u, int wr, int fr) {
    const float* bp = ssq + u.pm * 256 + wr * 64 + fr;
#define PG8_RL(i, OFS) asm volatile("global_load_dword %0, %1, off offset:" #OFS : "=v"(rsv[i]) : "v"(bp) : "memory")
    PG8_RL(0, 0); PG8_RL(1, 64); PG8_RL(2, 128); PG8_RL(3, 192); PG8_RL(4, 512); PG8_RL(5, 576); PG8_RL(6, 640); PG8_RL(7, 704);
#undef PG8_RL
  }
  __device__ __forceinline__ void operator()(const f32x4 (&acc)[2][2][4][2], const pg8::Unit& u, int wr, int wc, int fr, int fq) const {
#pragma unroll
    for (int ai = 0; ai < 2; ++ai)
#pragma unroll
      for (int m = 0; m < 4; ++m) {
        const int row = u.pm * 256 + ai * 128 + wr * 64 + m * 16 + fr; const float rs = rsqrtf(rsv[ai * 4 + m] * (1.f / 1024.f) + EPS);
#pragma unroll
        for (int bj = 0; bj < 2; ++bj) {
          const f32x4 v0 = acc[ai][bj][m][0] * rs, v1 = acc[ai][bj][m][1] * rs;
          u32x4 w; w.x = cvt_pk_bf16(v0[0], v0[1]); w.y = cvt_pk_bf16(v0[2], v0[3]); w.z = cvt_pk_bf16(v1[0], v1[1]); w.w = cvt_pk_bf16(v1[2], v1[3]);
          *(u32x4*)(q + (size_t)row * 2048 + u.pn * 256 + bj * 128 + wc * 32 + 8 * fq) = w;
        }
      }
  }
};


namespace peer {
constexpr int TCH = 256, NCH = T / TCH;
__device__ __forceinline__ unsigned xcc_id() { return (unsigned)__builtin_amdgcn_s_getreg((3 << 11) | 20) & 0xFu; }
__device__ __forceinline__ float shx(float v, int m) { return __shfl_xor(v, m); }
template <int M2, int M1, int M0>
__device__ __forceinline__ void reduce16(const float (&a)[16], int lane, float& r0, float& r1) {
  const bool b2 = lane & M2, b1 = lane & M1, b0 = lane & M0;
  float b[8], c[4];
#pragma unroll
  for (int k = 0; k < 8; ++k) { const float mine = b2 ? a[k + 8] : a[k], send = b2 ? a[k] : a[k + 8]; b[k] = mine + shx(send, M2); }
#pragma unroll
  for (int k = 0; k < 4; ++k) { const float mine = b1 ? b[k + 4] : b[k], send = b1 ? b[k] : b[k + 4]; c[k] = mine + shx(send, M1); }
  { const float mine = b0 ? c[2] : c[0], send = b0 ? c[0] : c[2]; r0 = mine + shx(send, M0); }
  { const float mine = b0 ? c[3] : c[1], send = b0 ? c[1] : c[3]; r1 = mine + shx(send, M0); }
}
template <int M2, int M1, int M0>
__device__ __forceinline__ void reduce16i(const int (&a)[16], int lane, int& r0, int& r1) {
  const bool b2 = lane & M2, b1 = lane & M1, b0 = lane & M0;
  int b[8], c[4];
#pragma unroll
  for (int k = 0; k < 8; ++k) { const int mine = b2 ? a[k + 8] : a[k], send = b2 ? a[k] : a[k + 8]; b[k] = mine + __shfl_xor(send, M2); }
#pragma unroll
  for (int k = 0; k < 4; ++k) { const int mine = b1 ? b[k + 4] : b[k], send = b1 ? b[k] : b[k + 4]; c[k] = mine + __shfl_xor(send, M1); }
  { const int mine = b0 ? c[2] : c[0], send = b0 ? c[0] : c[2]; r0 = mine + __shfl_xor(send, M0); }
  { const int mine = b0 ? c[3] : c[1], send = b0 ? c[1] : c[3]; r1 = mine + __shfl_xor(send, M0); }
}
constexpr float XQ_CLAMP = 6.f;
struct TokE { u32x4 e[2]; };
template <bool UP> struct TokD { u32x4 raw[16]; u32x4 aux; bf16x8 x0, x1; float rs; unsigned xr; };
__device__ __forceinline__ void tok_ids(const Params& p, int t, int lane, TokE& in) {
  const u32x4* ep = (const u32x4*)((const unsigned short*)(p.ws + OFF_EID) + (size_t)t * 128 + (lane >> 3) * 16);
  in.e[0] = ep[0]; in.e[1] = ep[1];
}
template <bool UP> __device__ __forceinline__ void tok_gather(const Params& p, const unsigned char* base, int slab, int t, int lane, const TokE& in, TokD<UP>& d) {
#pragma unroll
  for (int i = 0; i < 16; ++i) { const unsigned w = in.e[i >> 3][(i >> 1) & 3]; d.raw[i] = *(const u32x4*)(base + (size_t)((i & 1) ? (w >> 16) : (w & 0xffffu)) * 128); }
  if (UP) { d.aux = *(const u32x4*)((const unsigned char*)(p.ws + OFF_WQ8) + (size_t)t * 128 + (lane >> 3) * 16);
    d.xr = *(const unsigned*)((const bf16_t*)(p.ws + OFF_X1B) + (size_t)t * 1024 + slab * 128 + (lane & 7) * 16 + 2 * (lane >> 3)); }
  else { const bf16_t* xp = (const bf16_t*)(p.ws + OFF_X1B) + (size_t)t * 1024 + slab * 128 + (lane & 7) * 16; d.x0 = *(const bf16x8*)xp; d.x1 = *(const bf16x8*)(xp + 8); d.rs = ((const float*)(p.ws + OFF_SSQ1))[t]; }
}
__device__ __forceinline__ void down_compute(const Params& p, int slab, int t, int lane, const TokD<false>& d) {
  const int g = lane >> 3, c = lane & 7;
  int xq[4];
  { const float rs = rsqrtf(d.rs * (1.f / 1024.f) + EPS) * (127.f / XQ_CLAMP); int q[16];
#pragma unroll
    for (int k = 0; k < 8; ++k) { q[k] = __float2int_rn(fminf(fmaxf(bf2f((bf16_t)d.x0[k]) * rs, -127.f), 127.f)); q[8 + k] = __float2int_rn(fminf(fmaxf(bf2f((bf16_t)d.x1[k]) * rs, -127.f), 127.f)); }
#pragma unroll
    for (int i = 0; i < 4; ++i) xq[i] = (int)((unsigned)(q[4 * i] & 255) | ((unsigned)(q[4 * i + 1] & 255) << 8) | ((unsigned)(q[4 * i + 2] & 255) << 16) | ((unsigned)q[4 * i + 3] << 24)); }
  int acc[16];
#pragma unroll
  for (int i = 0; i < 16; ++i) { int a = 0;
#pragma unroll
    for (int w = 0; w < 4; ++w) a = __builtin_amdgcn_sdot4((int)d.raw[i][w], xq[w], a, false);
    acc[i] = a; }
  int r0, r1; reduce16i<4, 2, 1>(acc, lane, r0, r1);
  *(unsigned*)((bf16_t*)(p.ws + OFF_PART) + ((size_t)slab * T + t) * 128 + 16 * g + 2 * c) = cvt_pk_bf16((float)r0 * (XQ_CLAMP / 127.f), (float)r1 * (XQ_CLAMP / 127.f));
}
__device__ __forceinline__ void up_compute(const Params& p, int slab, int t, int lane, const TokD<true>& d) {
  const int g = lane >> 3, c = lane & 7;
  int o[16];
#pragma unroll
  for (int k = 0; k < 16; ++k) o[k] = 0;
#pragma unroll
  for (int a = 0; a < 4; ++a)
#pragma unroll
    for (int w = 0; w < 4; ++w) {
      const unsigned r0 = d.raw[4 * a][w], r1 = d.raw[4 * a + 1][w], r2 = d.raw[4 * a + 2][w], r3 = d.raw[4 * a + 3][w];
      const unsigned lo01 = __builtin_amdgcn_perm(r1, r0, 0x05010400u), hi01 = __builtin_amdgcn_perm(r1, r0, 0x07030602u);
      const unsigned lo23 = __builtin_amdgcn_perm(r3, r2, 0x05010400u), hi23 = __builtin_amdgcn_perm(r3, r2, 0x07030602u);
      const unsigned c0 = __builtin_amdgcn_perm(lo23, lo01, 0x05040100u), c1 = __builtin_amdgcn_perm(lo23, lo01, 0x07060302u);
      const unsigned c2 = __builtin_amdgcn_perm(hi23, hi01, 0x05040100u), c3 = __builtin_amdgcn_perm(hi23, hi01, 0x07060302u);
      o[4 * w] = __builtin_amdgcn_sdot4((int)c0, (int)d.aux[a], o[4 * w], false); o[4 * w + 1] = __builtin_amdgcn_sdot4((int)c1, (int)d.aux[a], o[4 * w + 1], false);
      o[4 * w + 2] = __builtin_amdgcn_sdot4((int)c2, (int)d.aux[a], o[4 * w + 2], false); o[4 * w + 3] = __builtin_amdgcn_sdot4((int)c3, (int)d.aux[a], o[4 * w + 3], false);
    }
  int r0, r1; reduce16i<32, 16, 8>(o, lane, r0, r1);
  const float ws = ((const float*)(p.ws + OFF_WSC))[t];
  *(unsigned*)((bf16_t*)(p.ws + OFF_PO) + (size_t)t * 1024 + slab * 128 + c * 16 + 2 * g) = cvt_pk_bf16(fmaf((float)r0, ws, __uint_as_float(d.xr << 16)), fmaf((float)r1, ws, __uint_as_float(d.xr & 0xffff0000u)));
}
template <bool UP, int NTOK>
__device__ __forceinline__ void gather_wave(const Params& p, int slab, int t0, int lane) {
  const unsigned char* base = (const unsigned char*)(p.ws + (UP ? OFF_V8 : OFF_U8)) + (size_t)slab * (16384 * 128) + (lane & 7) * 16;
  TokE eA, eB; TokD<UP> dA, dB;
  tok_ids(p, t0, lane, eA); tok_ids(p, t0 + 1, lane, eB);
  tok_gather<UP>(p, base, slab, t0, lane, eA, dA);
  for (int k = 0; k < NTOK; k += 2) {
    tok_gather<UP>(p, base, slab, t0 + k + 1, lane, eB, dB);
    tok_ids(p, (k + 2 < NTOK) ? t0 + k + 2 : t0, lane, eA);
    if constexpr (UP) up_compute(p, slab, t0 + k, lane, dA); else down_compute(p, slab, t0 + k, lane, dA);
    if (k + 2 < NTOK) tok_gather<UP>(p, base, slab, t0 + k + 2, lane, eA, dA);
    tok_ids(p, (k + 3 < NTOK) ? t0 + k + 3 : t0, lane, eB);
    if constexpr (UP) up_compute(p, slab, t0 + k + 1, lane, dB); else down_compute(p, slab, t0 + k + 1, lane, dB);
  }
}
template <bool UP>
__device__ __forceinline__ void phase_gather(const Params& p, char* lds, int qoff = 0) {
  const int tid = otid(), wid = tid >> 6, lane = tid & 63;
  unsigned* qh = (unsigned*)(p.ws + OFF_QHEAD) + (UP ? 8 : 0) + qoff;
  int* bc = (int*)lds;
  const int my = (int)(xcc_id() & 7u);
  for (int pass = 0; pass < 8; ++pass) {
    const int slab = (my + pass) & 7;
    for (;;) {
      if (tid == 0) bc[0] = (int)atomicAdd(qh + slab, 1u);
      __syncthreads();
      const int ch = bc[0];
      __syncthreads();
      if (ch >= NCH) break;
      gather_wave<UP, TCH / 8>(p, slab, ch * TCH + wid * (TCH / 8), lane);
    }
  }
}
__device__ __forceinline__ void phase_finish(const Params& p) {
  const bf16_t* part = (const bf16_t*)(p.ws + OFF_PART); const unsigned short* eid = (const unsigned short*)(p.ws + OFF_EID); const float* gate = (const float*)(p.ws + OFF_GATE);
  const float* sc = (const float*)(p.ws + OFF_USC);
  const int tid_ = otid(), wid = tid_ >> 6, lane = tid_ & 63;
  for (int tb = (blockIdx.x * 8 + wid) * 4; tb < T; tb += gridDim.x * 32) {
    unsigned pw[4][8]; u32x2 gt[4];
#pragma unroll
    for (int r = 0; r < 4; ++r) { const size_t i = (size_t)(tb + r) * 128 + 2 * lane; gt[r] = *(const u32x2*)(gate + i);
#pragma unroll
      for (int sl = 0; sl < 8; ++sl) pw[r][sl] = *(const unsigned*)(part + (size_t)sl * T * 128 + i); }
#pragma unroll
    for (int r = 0; r < 4; ++r) { const size_t i = (size_t)(tb + r) * 128 + 2 * lane;
      float s0 = 0.f, s1 = 0.f;
#pragma unroll
      for (int sl = 0; sl < 8; ++sl) { s0 += __uint_as_float(pw[r][sl] << 16); s1 += __uint_as_float(pw[r][sl] & 0xffff0000u); }
      s0 *= __uint_as_float(gt[r].x & 0xffff0000u); s1 *= __uint_as_float(gt[r].y & 0xffff0000u);
      const float h0 = __uint_as_float(gt[r].x << 16) * 0.5f * s0 * (1.f + erff(s0 * 0.70710678118654752f));
      const float h1 = __uint_as_float(gt[r].y << 16) * 0.5f * s1 * (1.f + erff(s1 * 0.70710678118654752f));
      const float am = wave_max(fmaxf(fabsf(h0), fabsf(h1)));
      const float inv = am > 0.f ? 127.f / am : 0.f;
      const int q0 = __float2int_rn(h0 * inv), q1 = __float2int_rn(h1 * inv);
      *(unsigned short*)((unsigned char*)(p.ws + OFF_WQ8) + i) = (unsigned short)((q0 & 255) | ((q1 & 255) << 8));
      if (lane == 0) ((float*)(p.ws + OFF_WSC))[tb + r] = am * (1.f / 127.f); }
  }
}
__device__ __forceinline__ void phase_final(const Params& p) {
  const int tid_ = otid(), wid = tid_ >> 6, lane = tid_ & 63; const bf16_t* po = (const bf16_t*)(p.ws + OFF_PO);
  struct Rows { u32x2 pw[4][4]; };
  auto ldrows = [&](int t0, Rows& R) {
#pragma unroll
    for (int r = 0; r < 4; ++r)
#pragma unroll
      for (int i = 0; i < 4; ++i) R.pw[r][i] = *(const u32x2*)(po + (size_t)(t0 + r) * 1024 + (lane + 64 * i) * 4); };
  auto dorows = [&](int t0, Rows& R) {
    float ss[4];
#pragma unroll
    for (int r = 0; r < 4; ++r) { float s_ = 0.f;
#pragma unroll
      for (int i = 0; i < 4; ++i) { const float a = __uint_as_float(R.pw[r][i].x << 16), b = __uint_as_float(R.pw[r][i].x & 0xffff0000u), c = __uint_as_float(R.pw[r][i].y << 16), d = __uint_as_float(R.pw[r][i].y & 0xffff0000u);
        s_ += a * a + b * b + c * c + d * d; }
      ss[r] = rsqrtf(wave_sum(s_) * (1.f / 1024.f) + EPS); }
#pragma unroll
    for (int i = 0; i < 4; ++i) { const f32x4 g4 = *(const f32x4*)(p.fg + (lane + 64 * i) * 4);
#pragma unroll
      for (int r = 0; r < 4; ++r) { const f32x4 v = (f32x4){__uint_as_float(R.pw[r][i].x << 16), __uint_as_float(R.pw[r][i].x & 0xffff0000u), __uint_as_float(R.pw[r][i].y << 16), __uint_as_float(R.pw[r][i].y & 0xffff0000u)};
        ((f32x4*)(p.out + (size_t)(t0 + r) * 1024))[lane + 64 * i] = v * g4 * ss[r]; } } };
  Rows RA, RB; const int st2 = gridDim.x * 32; int t0 = (blockIdx.x * 8 + wid) * 4;
  if (t0 < T) ldrows(t0, RA);
  for (; t0 < T; t0 += 2 * st2) {
    if (t0 + st2 < T) ldrows(t0 + st2, RB);
    dorows(t0, RA);
    if (t0 + st2 < T) { if (t0 + 2 * st2 < T) ldrows(t0 + 2 * st2, RA); dorows(t0 + st2, RB); }
  }
}
}


namespace topk {
using att::f32x16; using att::ld8;
__device__ __forceinline__ void ce(float& a, float& b) {
  float mx, mn; asm("v_max_f32 %0, %1, %2" : "=v"(mx) : "v"(a), "v"(b)); asm("v_min_f32 %0, %1, %2" : "=v"(mn) : "v"(a), "v"(b)); a = mx; b = mn; }
__device__ __forceinline__ void sort16(float (&a)[16]) {
#pragma unroll
  for (int p = 1; p < 16; p *= 2)
#pragma unroll
    for (int k = p; k >= 1; k /= 2)
#pragma unroll
      for (int j = k % p; j <= 15 - k; j += 2 * k)
#pragma unroll
        for (int i = 0; i < (k < 16 - j - k ? k : 16 - j - k); ++i)
          if ((i + j) / (2 * p) == (i + j + k) / (2 * p)) ce(a[i + j], a[i + j + k]);
}
__device__ __forceinline__ void merge16(float (&a)[16], const float (&b)[16]) {
#pragma unroll
  for (int i = 0; i < 16; ++i) { float mx; asm("v_max_f32 %0, %1, %2" : "=v"(mx) : "v"(a[i]), "v"(b[15 - i])); a[i] = mx; }
#pragma unroll
  for (int j = 8; j > 0; j >>= 1)
#pragma unroll
    for (int i = 0; i < 16; ++i) { const int l = i ^ j; if (l > i) ce(a[i], a[l]); }
}
#define TKSWZ(row, colB) ((row) * 256 + ((colB) ^ (((row) & 7) << 4)))
__device__ __forceinline__ void stage_keys(const Params& p, int h, char* lds) {
  const bf16_t* kb = (const bf16_t*)(p.ws + OFF_KEYS) + (size_t)h * 2 * 128 * 128;
#pragma unroll
  for (int i = 0; i < 8; ++i) { const int q = otid() + 512 * i, row = q >> 4, c8 = (q & 15) * 8;
    *(bf16x8*)(lds + TKSWZ(row, c8 * 2)) = ld8(kb + (size_t)row * 128 + c8); }
}
__device__ __forceinline__ void load_q(const Params& p, int it, int ph, int wid, int lane, bf16x8 (&qf)[8]) {
  const int r32 = lane & 31, hi = lane >> 5, h = it & 7, t0 = (it >> 3) * 256 + wid * 32;
  const bf16_t* q = (const bf16_t*)(p.ws + OFF_Q) + (size_t)(t0 + r32) * 2048 + h * 256 + ph * 128 + hi * 8;
#pragma unroll
  for (int i = 0; i < 8; ++i) qf[i] = ld8(q + i * 16);
}
__device__ __forceinline__ void item(const Params& p, int it, int itn, int wid, int lane, const char* lds, bf16x8 (&qf)[8]) {
  const int r32 = lane & 31, hi = lane >> 5, h = it & 7, t0 = (it >> 3) * 256 + wid * 32;
  float L[2][16];
#pragma unroll
  for (int ph = 0; ph < 2; ++ph) {
    f32x16 acc[4] = {};
    bf16x8 af[2][4];
#pragma unroll
    for (int kb = 0; kb < 4; ++kb) af[0][kb] = *(const bf16x8*)(lds + TKSWZ(ph * 128 + kb * 32 + r32, (hi * 8) * 2));
#pragma unroll
    for (int ks = 0; ks < 8; ++ks) {
      if (ks + 1 < 8) {
#pragma unroll
        for (int kb = 0; kb < 4; ++kb) af[(ks + 1) & 1][kb] = *(const bf16x8*)(lds + TKSWZ(ph * 128 + kb * 32 + r32, ((ks + 1) * 16 + hi * 8) * 2)); }
#pragma unroll
      for (int kb = 0; kb < 4; ++kb) acc[kb] = __builtin_amdgcn_mfma_f32_32x32x16_bf16(af[ks & 1][kb], qf[ks], acc[kb], 0, 0, 0);
      __builtin_amdgcn_sched_barrier(0); }
    if (ph == 0) load_q(p, it, 1, wid, lane, qf); else if (itn >= 0) load_q(p, itn, 0, wid, lane, qf);
    float g[4][16];
#pragma unroll
    for (int kb = 0; kb < 4; ++kb)
#pragma unroll
      for (int r = 0; r < 16; ++r) g[kb][r] = __uint_as_float((__float_as_uint(acc[kb][r]) & 0xFFFFFF80u) | (unsigned)(kb * 32 + (r & 3) + 8 * (r >> 2)));
    sort16(g[0]); sort16(g[1]); sort16(g[2]); sort16(g[3]);
    merge16(g[0], g[1]); merge16(g[2], g[3]); merge16(g[0], g[2]);
#pragma unroll
    for (int i = 0; i < 16; ++i) L[ph][i] = __uint_as_float(__float_as_uint(g[0][i]) | (unsigned)(hi * 4));
  }
  float A[16], B[16];
  { float M1[16], M2[16];
#pragma unroll
    for (int i = 0; i < 16; ++i) { auto r = __builtin_amdgcn_permlane32_swap(__float_as_uint(L[0][i]), __float_as_uint(L[1][i]), false, false); M1[i] = __uint_as_float(r[0]); M2[i] = __uint_as_float(r[1]); }
    merge16(M1, M2);
#pragma unroll
    for (int i = 0; i < 16; ++i) { auto r = __builtin_amdgcn_permlane32_swap(__float_as_uint(M1[i]), __float_as_uint(M1[i]), false, false); A[i] = __uint_as_float(r[0]); B[i] = __uint_as_float(r[1]); } }
  unsigned ia[16], ib[16];
#pragma unroll
  for (int i = 0; i < 16; ++i) { ia[i] = (__float_as_uint(A[i]) & 0x7Fu) << 7; ib[i] = __float_as_uint(B[i]) & 0x7Fu; }
#define CAND(i, j) __uint_as_float((__float_as_uint(A[i] + B[j]) & 0xFFFFC000u) | ia[i] | ib[j])
  const float NEG = -3.0e38f;
  float G0[16], G1[16], G2[16], G3[16];
#pragma unroll
  for (int j = 0; j < 16; ++j) G0[j] = CAND(0, j);
#pragma unroll
  for (int j = 0; j < 8; ++j) G1[j] = CAND(1, j);
#pragma unroll
  for (int j = 0; j < 5; ++j) G1[8 + j] = CAND(2, j);
#pragma unroll
  for (int j = 0; j < 3; ++j) G1[13 + j] = CAND(3, j);
  G2[0] = CAND(3, 3); G2[1] = CAND(4, 0); G2[2] = CAND(4, 1); G2[3] = CAND(4, 2); G2[4] = CAND(5, 0); G2[5] = CAND(5, 1); G2[6] = CAND(6, 0); G2[7] = CAND(6, 1);
  G2[8] = CAND(7, 0); G2[9] = CAND(7, 1); G2[10] = CAND(8, 0); G2[11] = CAND(9, 0); G2[12] = CAND(10, 0); G2[13] = CAND(11, 0); G2[14] = CAND(12, 0); G2[15] = CAND(13, 0);
  G3[0] = CAND(14, 0); G3[1] = CAND(15, 0);
#pragma unroll
  for (int j = 2; j < 16; ++j) G3[j] = NEG;
#undef CAND
  ce(G3[0], G3[1]);
  sort16(G0); sort16(G1); sort16(G2);
  merge16(G0, G1); merge16(G2, G3); merge16(G0, G2);
  float e[16], sum = 0.f; const float s0 = __uint_as_float(__float_as_uint(G0[0]) & 0xFFFFC000u);
#pragma unroll
  for (int k = 0; k < 16; ++k) { e[k] = __expf(__uint_as_float(__float_as_uint(G0[k]) & 0xFFFFC000u) - s0); sum += e[k]; }
  const float inv = 1.f / sum;
  unsigned short* eo = (unsigned short*)(p.ws + OFF_EID) + (size_t)(t0 + r32) * 128 + h * 16 + hi * 8; float* go = (float*)(p.ws + OFF_GATE) + (size_t)(t0 + r32) * 128 + h * 16 + hi * 8;
  u32x4 e0; f32x4 g0, g1; const unsigned hm = (unsigned)(-hi);
#define SELU(a, b) (__float_as_uint(b) ^ ((__float_as_uint(a) ^ __float_as_uint(b)) & hm))
#pragma unroll
  for (int k = 0; k < 4; ++k) { e0[k] = (SELU(G0[8 + 2 * k], G0[2 * k]) & 0x3FFFu) | ((SELU(G0[9 + 2 * k], G0[2 * k + 1]) & 0x3FFFu) << 16);
    g0[k] = __uint_as_float(SELU(e[8 + k], e[k])) * inv; g1[k] = __uint_as_float(SELU(e[12 + k], e[4 + k])) * inv; }
#undef SELU
  const float* sc_ = (const float*)(p.ws + OFF_USC); u32x4 w0, w1;
#pragma unroll
  for (int k = 0; k < 4; ++k) { const unsigned ea = e0[k >> 1] >> (16 * (k & 1)) & 0xffffu, eb = e0[2 + (k >> 1)] >> (16 * (k & 1)) & 0xffffu;
    w0[k] = cvt_pk_bf16(g0[k] * sc_[16384 + ea], sc_[ea]); w1[k] = cvt_pk_bf16(g1[k] * sc_[16384 + eb], sc_[eb]); }
  *(u32x4*)eo = e0; *(u32x4*)go = w0; *(u32x4*)(go + 4) = w1;
}
}

template <int PH> __device__ __forceinline__ void run_phase(const Params& p, char* smem) {
  if constexpr (PH == 0) phase_prep(p, smem);
  if constexpr (PH == 1) {
    pg8::Gemm g{(const bf16_t*)(p.ws + OFF_XB), (const bf16_t*)(p.ws + OFF_WIN), T, 3072, 1024};
    pg8::BalancedOrder So; So.init(T, 3072, gridDim.x, blockIdx.x);
    EpiInproj E{p.ws, (const float*)(p.ws + OFF_RSTD0), (unsigned*)(p.ws + OFF_KN)};
    pg8::gemm_phase(( LAS unsigned char*)smem, g, So, E);
  }
  if constexpr (PH == 2) phase_attn(p, smem);
  if constexpr (PH == 3) ret::phase_states(p, smem);
  if constexpr (PH == 4) ret::phase_scan(p);
  if constexpr (PH == 5) ret::phase_retout(p, smem);
  if constexpr (PH == 6) {
    pg8::Gemm g{(const bf16_t*)(p.ws + OFF_MIX), (const bf16_t*)(p.ws + OFF_WOUT), T, 1024, 1024};
    pg8::StaticOrder So; So.init(T, 1024, gridDim.x, blockIdx.x);
    EpiOutproj E{(const bf16_t*)(p.ws + OFF_XB), (bf16_t*)(p.ws + OFF_X1B), (float*)(p.ws + OFF_SSQ1)};
    pg8::gemm_phase((LAS unsigned char*)smem, g, So, E);
  }
  if constexpr (PH == 8) {
    const int tid_ = otid(), wid = tid_ >> 6, lane = tid_ & 63; int hcur = -1; bf16x8 qf[8];
    pg8::StaticOrder So; So.init(T, 2048, gridDim.x, blockIdx.x);
    asm volatile("s_waitcnt vmcnt(0)" ::: "memory"); __syncthreads();
    unsigned long long w0, w1;
    { unsigned key[8];
#pragma unroll
      for (int i = 0; i < 8; ++i) { pg8::Unit t; key[i] = So.next(i, t) ? (((unsigned)t.pn << 27) | ((unsigned)i << 24) | (unsigned)((t.pm << 3) | t.pn)) : 0xffffffffu; }
#define SC(a, b) do { const unsigned lo_ = key[a] < key[b] ? key[a] : key[b], hi_ = key[a] < key[b] ? key[b] : key[a]; key[a] = lo_; key[b] = hi_; } while (0)
      SC(0, 1); SC(2, 3); SC(4, 5); SC(6, 7); SC(0, 2); SC(1, 3); SC(4, 6); SC(5, 7); SC(1, 2); SC(5, 6); SC(0, 4); SC(1, 5); SC(2, 6); SC(3, 7); SC(2, 4); SC(3, 5); SC(1, 2); SC(3, 4); SC(5, 6);
#undef SC
      w0 = w1 = 0ull;
#pragma unroll
      for (int i = 0; i < 4; ++i) { w0 |= (unsigned long long)(key[i] == 0xffffffffu ? 0xffffu : (key[i] & 0x3ffu)) << (16 * i); w1 |= (unsigned long long)(key[4 + i] == 0xffffffffu ? 0xffffu : (key[4 + i] & 0x3ffu)) << (16 * i); } }
    auto item_of = [&](int k) -> int {
      if (k < 8) { const unsigned v = (unsigned)(((k < 4 ? w0 : w1) >> (16 * (k & 3))) & 0xffffull); return v == 0xffffu ? -1 : (int)v; }
      pg8::Unit t; return So.next(k, t) ? ((t.pm << 3) | t.pn) : -1; };
    int it = item_of(0);
    if (it >= 0) topk::load_q(p, it, 0, wid, lane, qf);
    for (int k = 0; it >= 0; ++k) {
      const int itn = item_of(k + 1);
      if ((it & 7) != hcur) { __syncthreads(); hcur = it & 7; topk::stage_keys(p, hcur, smem); __syncthreads(); }
      topk::item(p, it, itn, wid, lane, smem, qf);
      it = itn;
    }
    __syncthreads();
  }
  if constexpr (PH == 9) peer::phase_gather<false>(p, smem);
  if constexpr (PH == 10) peer::phase_finish(p);
  if constexpr (PH == 11) peer::phase_gather<true>(p, smem);
  if constexpr (PH == 12) peer::phase_final(p);
  if constexpr (PH == 7) {
    pg8::Gemm g{(const bf16_t*)(p.ws + OFF_X1B), (const bf16_t*)(p.ws + OFF_WQ), T, 2048, 1024};
    pg8::StaticOrder So; So.init(T, 2048, gridDim.x, blockIdx.x);
    EpiQ E{(const float*)(p.ws + OFF_SSQ1), (bf16_t*)(p.ws + OFF_Q)};
    pg8::gemm_phase((LAS unsigned char*)smem, g, So, E);
  }
}


#define XB_TMO      128
#define XB_XCNT(j)  (256  + 64 * (j))
#define XB_XSUB(j)  (1280 + 64 * (j))
#define XB_XGEN(j)  (2304 + 64 * (j))
#define XB_TOP      3328
#define XB_TOPGEN   3392
#define XCD_BAR_WORDS 3456
#define XB_SPIN_CAP (1u << 22)
__device__ __forceinline__ unsigned xb_ld(unsigned* p)              { return __hip_atomic_load(p, __ATOMIC_RELAXED, __HIP_MEMORY_SCOPE_AGENT); }
__device__ __forceinline__ unsigned xb_add(unsigned* p, unsigned v) { return __hip_atomic_fetch_add(p, v, __ATOMIC_RELAXED, __HIP_MEMORY_SCOPE_AGENT); }
__device__ __forceinline__ unsigned xb_xcc_id() { return (unsigned)__builtin_amdgcn_s_getreg((3 << 11) | 20) & 0xFu; }
#define XB_SPIN(cond, bar) do { unsigned _sp = 0; while (cond) { __builtin_amdgcn_s_sleep(1); \
    if ((++_sp & 255u) == 0u) { if (xb_ld(&(bar)[XB_TMO])) break; if (_sp > XB_SPIN_CAP) { atomicAdd(&(bar)[XB_TMO], 1u); break; } } } } while (0)
struct XcdBarrier { unsigned* bar; unsigned x; volatile LAS unsigned* st; };
__device__ __forceinline__ XcdBarrier xcd_barrier_post(unsigned* bar, volatile LAS unsigned* st) {
  XcdBarrier b; b.bar = bar; b.x = xb_xcc_id(); b.st = st;
  if (threadIdx.x == 0) (void)xb_add(&bar[XB_XCNT(b.x)], 1u);
  return b;
}
__device__ __forceinline__ void xcd_barrier_complete(unsigned* bar, unsigned x, unsigned& nloc, unsigned& nx) {
  const unsigned G = gridDim.x * gridDim.y * gridDim.z;
  unsigned sum, cnt, mine, sp = 0u;
  for (;;) {
    sum = 0u; cnt = 0u; mine = 0u;
#pragma unroll
    for (unsigned j = 0; j < 16; ++j) { const unsigned c = xb_ld(&bar[XB_XCNT(j)]); sum += c; cnt += (c > 0u) ? 1u : 0u; mine = (j == x) ? c : mine; }
    if (sum == G) break;
    __builtin_amdgcn_s_sleep(1);
    if ((++sp & 255u) == 0u) { if (xb_ld(&bar[XB_TMO])) break; if (sp > XB_SPIN_CAP) { atomicAdd(&bar[XB_TMO], 1u); break; } }
  }
  nloc = mine > 0u ? mine : 1u; nx = cnt > 0u ? cnt : 1u;
}
__device__ __forceinline__ void xcd_barrier(const XcdBarrier& b) {
  asm volatile("s_waitcnt vmcnt(0)" ::: "memory");
  __syncthreads();
  if (threadIdx.x == 0) {
    unsigned* bar = b.bar;
    __builtin_amdgcn_s_waitcnt(0);
    unsigned nloc = b.st[0], nx = b.st[1];
    if (nloc == 0u) { xcd_barrier_complete(bar, b.x, nloc, nx); b.st[0] = nloc; b.st[1] = nx; }
    const unsigned old = xb_add(&bar[XB_XSUB(b.x)], 1u);
    const unsigned gen = old / nloc;
    if (old + 1u == (gen + 1u) * nloc) {
      __builtin_amdgcn_fence(__ATOMIC_RELEASE, "agent");
      asm volatile("s_waitcnt vmcnt(0)" ::: "memory");
      const unsigned og = xb_add(&bar[XB_TOP], 1u);
      const unsigned tg = og / nx;
      if (og + 1u == (tg + 1u) * nx) xb_add(&bar[XB_TOPGEN], 1u);
      else XB_SPIN(xb_ld(&bar[XB_TOPGEN]) == tg, bar);
      __builtin_amdgcn_fence(__ATOMIC_ACQUIRE, "agent");
      xb_add(&bar[XB_XGEN(b.x)], 1u);
      asm volatile("s_waitcnt vmcnt(0)" ::: "memory");
    } else {
      XB_SPIN(xb_ld(&bar[XB_XGEN(b.x)]) == gen, bar);
      __builtin_amdgcn_fence(__ATOMIC_ACQUIRE, "agent");
      asm volatile("s_waitcnt vmcnt(0)" ::: "memory");
    }
  }
  __syncthreads();
}

template <int PH> __global__ __launch_bounds__(512, 2) void k_phase(Params p) {
  extern __shared__ __attribute__((aligned(16))) char smem[];
  run_phase<PH>(p, smem);
}
__global__ __launch_bounds__(512, 2) void mega(Params p) {
  extern __shared__ __attribute__((aligned(16))) char smem[];
  cooperative_groups::grid_group grid = cooperative_groups::this_grid();
  volatile LAS unsigned* st = (volatile LAS unsigned*)(LAS unsigned char*)(smem + LDS_ST_OFF);
  if (threadIdx.x == 0) { st[0] = 0u; st[1] = 0u; st[2] = 0u; st[3] = 0u; }
  __syncthreads();
  const XcdBarrier xb = xcd_barrier_post((unsigned*)(p.ws + OFF_BAR), st);
#ifndef PROBE_DUP
#define PROBE_DUP -1
#endif
#define DUP(k) do { if (PROBE_DUP == (k)) { xcd_barrier(xb); run_phase<(k)>(p, smem); } } while (0)
  run_phase<0>(p, smem); DUP(0); if (p.coop_sync) grid.sync(); xcd_barrier(xb);
  run_phase<1>(p, smem); DUP(1); xcd_barrier(xb);
  run_phase<3>(p, smem); DUP(3); xcd_barrier(xb);
  run_phase<4>(p, smem); run_phase<2>(p, smem); DUP(2); xcd_barrier(xb);
  run_phase<5>(p, smem); DUP(5); xcd_barrier(xb);
  if (PROBE_DUP == 345) { run_phase<3>(p, smem); xcd_barrier(xb); run_phase<4>(p, smem); xcd_barrier(xb); run_phase<5>(p, smem); xcd_barrier(xb); }
  run_phase<6>(p, smem); xcd_barrier(xb);
  run_phase<7>(p, smem); run_phase<8>(p, smem); if (PROBE_DUP == 8) run_phase<8>(p, smem); if (PROBE_DUP == 78) { xcd_barrier(xb); run_phase<7>(p, smem); run_phase<8>(p, smem); } xcd_barrier(xb);
  run_phase<9>(p, smem); if (PROBE_DUP == 9) { xcd_barrier(xb); peer::phase_gather<false>(p, smem, 16); } xcd_barrier(xb);
  run_phase<10>(p, smem); DUP(10); xcd_barrier(xb);
  run_phase<11>(p, smem); xcd_barrier(xb);
  run_phase<12>(p, smem);
}

}


extern "C" void kernel_launch(void* const* d_in, const int* in_sizes, int n_in, void* d_out, int out_size, void* d_ws, size_t ws_size, hipStream_t stream) {
  Params p{};
  p.x = (const float*)d_in[0]; p.attn_g = (const float*)d_in[1]; p.w_in = (const float*)d_in[2]; p.dlam = (const float*)d_in[3]; p.dng = (const float*)d_in[4];
  p.rld = (const float*)d_in[5]; p.rng_ = (const float*)d_in[6]; p.w_out = (const float*)d_in[7]; p.ffn_g = (const float*)d_in[8]; p.wq = (const float*)d_in[9];
  p.keys = (const float*)d_in[10]; p.pu = (const float*)d_in[11]; p.pv = (const float*)d_in[12]; p.fg = (const float*)d_in[13];
  p.out = (float*)d_out; p.ws = (char*)d_ws;
  if (ws_size < WS_NEED) { fprintf(stderr, "ws too small: %zu\n", ws_size); return; }
  static int grid_blocks = 0;
  if (!grid_blocks) {
    (void)hipFuncSetAttribute((const void*)mega, hipFuncAttributeMaxDynamicSharedMemorySize, LDS_BYTES);
    int dev = 0, cus = 0, per_cu = 0;
    (void)hipGetDevice(&dev); (void)hipDeviceGetAttribute(&cus, hipDeviceAttributeMultiprocessorCount, dev);
    (void)hipOccupancyMaxActiveBlocksPerMultiprocessor(&per_cu, (const void*)mega, 512, LDS_BYTES);
    if (per_cu > 1) per_cu = 1;
    grid_blocks = cus * per_cu;
    if (grid_blocks <= 0) { fprintf(stderr, "occupancy query failed: cus %d per_cu %d\n", cus, per_cu); grid_blocks = 0; return; }
  }
  (void)hipMemsetAsync((char*)d_ws + OFF_BAR, 0, 16 * 1024, stream);
  void* args[] = {&p};
  hipError_t e = hipLaunchCooperativeKernel((const void*)mega, dim3(grid_blocks), dim3(512), args, LDS_BYTES, stream);
  if (e != hipSuccess) fprintf(stderr, "cooperative launch failed: %s (grid %d)\n", hipGetErrorString(e), grid_blocks);
}
```

```cpp
#include <hip/hip_runtime.h>
#include <hip/hip_cooperative_groups.h>
#include <stdint.h>
#include <cstdio>

namespace {
constexpr int T = 32768, S = 4096, NB = 8, DM = 1024, INC = 3072;
constexpr float EPS = 1e-6f;
typedef unsigned short bf16_t;
typedef short bf16x8 __attribute__((ext_vector_type(8)));
typedef float f32x4 __attribute__((ext_vector_type(4)));
typedef float f32x2 __attribute__((ext_vector_type(2)));
typedef unsigned u32x4 __attribute__((ext_vector_type(4)));
typedef unsigned u32x2 __attribute__((ext_vector_type(2)));
#define LAS __attribute__((address_space(3)))

__device__ __forceinline__ float bf2f(bf16_t v) { return __uint_as_float(((unsigned)v) << 16); }
__device__ __forceinline__ bf16_t f2bf(float f) { unsigned u = __float_as_uint(f); u += 0x7fffu + ((u >> 16) & 1u); return (bf16_t)(u >> 16); }
__device__ __forceinline__ unsigned cvt_pk_bf16(float lo, float hi) { unsigned r; asm volatile("v_cvt_pk_bf16_f32 %0, %1, %2" : "=v"(r) : "v"(lo), "v"(hi)); return r; }
__device__ __forceinline__ int otid() { int t = threadIdx.x; asm volatile("" : "+v"(t)); return t; }
__device__ __forceinline__ float wave_sum(float v) { for (int o = 32; o > 0; o >>= 1) v += __shfl_xor(v, o); return v; }
__device__ __forceinline__ float wave_max(float v) { for (int o = 32; o > 0; o >>= 1) v = fmaxf(v, __shfl_xor(v, o)); return v; }

constexpr size_t MB = 1024ull * 1024ull, KB = 1024ull;
constexpr size_t OFF_QD = 0, OFF_KD = 32 * MB, OFF_VD = 64 * MB, OFF_RQ = 96 * MB, OFF_RK = 112 * MB, OFF_RV = 128 * MB, OFF_RG = 160 * MB;
constexpr size_t OFF_PART = 0;
constexpr size_t OFF_Q = 0;
constexpr size_t OFF_XB = 420 * MB;
constexpr size_t OFF_MIX = 192 * MB;
constexpr size_t OFF_X1B = 256 * MB;
constexpr size_t OFF_PO = 256 * MB;
constexpr size_t OFF_ST = 256 * MB;
constexpr size_t OFF_SST = 320 * MB;
constexpr size_t OFF_EID = 320 * MB, OFF_GATE = 336 * MB, OFF_HW = 352 * MB;
constexpr size_t OFF_WIN = 368 * MB, OFF_WOUT = 374 * MB, OFF_WQ = 376 * MB, OFF_KEYS = 380 * MB;
constexpr size_t OFF_U8 = 381 * MB, OFF_V8 = 397 * MB, OFF_USC = 413 * MB;
constexpr size_t OFF_ROPED = 414 * MB, OFF_ROPER = 414 * MB + 256 * KB;
constexpr size_t OFF_RSTD0 = 416 * MB, OFF_SSQ1 = 416 * MB + 128 * KB, OFF_RSTD1 = 416 * MB + 256 * KB, OFF_LAM = 416 * MB + 384 * KB, OFF_QHEAD = 416 * MB + 388 * KB, OFF_KN = 416 * MB + 392 * KB, OFF_WSC = 416 * MB + 512 * KB, OFF_WQ8 = OFF_HW, OFF_SSQ2 = 417 * MB, OFF_BAR = 418 * MB;
constexpr size_t WS_NEED = 484 * MB;
static_assert(OFF_SSQ2 + 1 * MB <= WS_NEED, "ws map");

constexpr int LDS_BYTES = 160 * 1024, LDS_ST_OFF = LDS_BYTES - 16;
struct Params {
  const float *x, *attn_g, *w_in, *dlam, *dng, *rld, *rng_, *w_out, *ffn_g, *wq, *keys, *pu, *pv, *fg;
  float* out; char* ws; int coop_sync; int pad_;
};

namespace pg8 {
constexpr int BM = 256, BK = 64, HALF = 128, HTB = HALF * BK * 2, STAGE_BYTES = 8 * HTB, NXCD = 8, WGM = 8;
__host__ __device__ __forceinline__ int lds_byte(int r, int c) { const int st = (r >> 4) * 2 + (c >> 5), rr = r & 15, cc = c & 31, ob = rr * 64 + cc * 2; return st * 1024 + (ob ^ (((ob >> 9) & 1) << 5)); }
__host__ __device__ __forceinline__ void stage_rc(int b, int& R, int& C) { const int st = b / 1024, sb = b % 1024, swz = sb ^ (((sb >> 9) & 1) << 5); R = (st >> 1) * 16 + swz / 64; C = (st & 1) * 32 + (swz % 64) / 2; }
__host__ __device__ __forceinline__ int perm32(int rho) { const int n = rho >> 4, i = rho & 15; return 8 * (i >> 2) + 4 * n + (i & 3); }
struct Unit { int pm, pn; };
struct Gemm { const bf16_t* A; const bf16_t* Bt; int M, N, K; };
struct StaticOrder {
  int nM, nN, nwg, G, c;
  __host__ __device__ void init(int M, int N, int G_, int c_) { nM = M / BM; nN = N / BM; nwg = nM * nN; G = G_; c = c_; }
  __host__ __device__ bool next(int i, Unit& u) const {
    const long L = (long)i * G + c; if (L >= nwg) return false;
    int wgid = (int)L; { const int q = nwg / NXCD, r = nwg % NXCD, xcd = wgid % NXCD, off = wgid / NXCD; wgid = (xcd < r ? xcd * (q + 1) : r * (q + 1) + (xcd - r) * q) + off; }
    const int nig = WGM * nN, gid = wgid / nig, fm = gid * WGM, gsz = (nM - fm) < WGM ? (nM - fm) : WGM;
    u.pm = fm + ((wgid % nig) % gsz); u.pn = (wgid % nig) / gsz; return true;
  }
};
struct BalancedOrder : StaticOrder {
  __host__ __device__ bool next(int i, Unit& u) const { if (!StaticOrder::next(i, u)) return false; u.pn ^= ((u.pm >> 3) & 1) << 1; return true; }
};
template <class Epi, class Order>
__device__ __forceinline__ void gemm_phase(LAS unsigned char* lds, const Gemm g, const Order& S, Epi& E) {
  int tid = threadIdx.x; asm volatile("" : "+v"(tid));
  const int wid = __builtin_amdgcn_readfirstlane(tid >> 6), lane = tid & 63, wr = wid >> 2, wc = wid & 3, fr = lane & 15, fq = lane >> 4;
  const int K = g.K, nt = K / BK;
  unsigned voffA[2], voffB[2];
#pragma unroll
  for (int i = 0; i < 2; ++i) { int R, C; stage_rc(tid * 16 + i * 8192, R, C); const int Rb = Epi::PERM ? ((R & ~31) + perm32(R & 31)) : R;
    voffA[i] = (unsigned)(R * K + C) * 2u; voffB[i] = (unsigned)(Rb * K + C) * 2u; }
  const size_t kstep = (size_t)(BK * 2);
  const size_t hstep = (size_t)HALF * K * 2;
  const size_t tstep = 2 * hstep;
  const unsigned ldsw = (unsigned)wid * 1024u;
  const int aoff = lds_byte(wr * 64 + fr, fq * 8), boff = lds_byte(wc * 32 + fr, fq * 8);
#define PG8_SA(b, h) (((b) * 2 + (h)) * HTB)
#define PG8_SB(b, h) ((4 + (b) * 2 + (h)) * HTB)
#define PG8_STAGE(bufoff, gbase, voff) do { _Pragma("unroll") for (int _i = 0; _i < 2; ++_i) \
    __builtin_amdgcn_global_load_lds((const unsigned*)((const char*)(gbase) + (voff)[_i]), (LAS unsigned*)(lds + (bufoff) + ldsw + _i * 8192), 16, 0, 0); } while (0)
#define PG8_LDA(dst, b, h) do { _Pragma("unroll") for (int m = 0; m < 4; ++m) _Pragma("unroll") for (int k = 0; k < 2; ++k) dst[m][k] = *(const LAS bf16x8*)(lds + PG8_SA(b, h) + aoff + m * 2048 + k * 1024); } while (0)
#define PG8_LDB(dst, b, h) do { _Pragma("unroll") for (int n = 0; n < 2; ++n) _Pragma("unroll") for (int k = 0; k < 2; ++k) dst[n][k] = *(const LAS bf16x8*)(lds + PG8_SB(b, h) + boff + n * 2048 + k * 1024); } while (0)
#define PG8_MMA(ai, bj, At, Bt) do { __builtin_amdgcn_s_setprio(1); _Pragma("unroll") for (int m = 0; m < 4; ++m) _Pragma("unroll") for (int n = 0; n < 2; ++n) _Pragma("unroll") for (int k = 0; k < 2; ++k) \
    acc[ai][bj][m][n] = __builtin_amdgcn_mfma_f32_16x16x32_bf16(Bt[n][k], At[m][k], acc[ai][bj][m][n], 0, 0, 0); __builtin_amdgcn_s_setprio(0); } while (0)
#define PG8_WAIT_V(n) asm volatile("s_waitcnt vmcnt(" #n ")" ::: "memory")
#define PG8_WAIT_L(n) asm volatile("s_waitcnt lgkmcnt(" #n ")" ::: "memory")
#define PG8_BAR __builtin_amdgcn_s_barrier()
#define PG8_SCHED __builtin_amdgcn_sched_barrier(0)
  Unit cur, nxt; int ui = 0;
  if (!S.next(0, cur)) return;
  f32x4 acc[2][2][4][2];
#pragma unroll
  for (int a = 0; a < 2; ++a)
#pragma unroll
    for (int b = 0; b < 2; ++b)
#pragma unroll
      for (int m = 0; m < 4; ++m)
#pragma unroll
        for (int n = 0; n < 2; ++n) acc[a][b][m][n] = (f32x4){0.f, 0.f, 0.f, 0.f};
  bf16x8 At[4][2], B0[2][2], B1[2][2];
  const char* cA = (const char*)g.A + (size_t)cur.pm * tstep; const char* cB = (const char*)g.Bt + (size_t)cur.pn * tstep;
  PG8_STAGE(PG8_SB(0, 0), cB, voffB); PG8_STAGE(PG8_SA(0, 0), cA, voffA); PG8_STAGE(PG8_SB(0, 1), cB + hstep, voffB); PG8_STAGE(PG8_SA(0, 1), cA + hstep, voffA);
  if (wr == 1) PG8_BAR;
  PG8_WAIT_V(4); PG8_BAR;
  PG8_STAGE(PG8_SB(1, 0), cB + kstep, voffB); PG8_STAGE(PG8_SA(1, 0), cA + kstep, voffA); PG8_STAGE(PG8_SB(1, 1), cB + hstep + kstep, voffB);
  PG8_WAIT_V(6); PG8_BAR;
  for (;;) {
    const bool has_next = S.next(ui + 1, nxt);
    E.pre(cur, wr, fr);
    const char* nA = has_next ? (const char*)g.A + (size_t)nxt.pm * tstep : cA; const char* nB = has_next ? (const char*)g.Bt + (size_t)nxt.pn * tstep : cB;
    for (int t = 0; t < nt; t += 2) {
      const bool last = (t == nt - 2);
      const char* a1 = cA + (size_t)(t + 1) * kstep;
      const char* a2 = last ? nA : cA + (size_t)(t + 2) * kstep; const char* b2 = last ? nB : cB + (size_t)(t + 2) * kstep;
      const char* a3 = a2 + kstep; const char* b3 = b2 + kstep;
      PG8_LDB(B0, 0, 0); PG8_SCHED; PG8_LDA(At, 0, 0); PG8_STAGE(PG8_SA(1, 1), a1 + hstep, voffA);
      PG8_WAIT_L(8); PG8_BAR; PG8_WAIT_L(0); PG8_MMA(0, 0, At, B0); PG8_BAR; PG8_SCHED;
      PG8_LDB(B1, 0, 1); PG8_STAGE(PG8_SB(0, 0), b2, voffB);
      PG8_BAR; PG8_WAIT_L(0); PG8_MMA(0, 1, At, B1); PG8_BAR;
      PG8_LDA(At, 0, 1); PG8_STAGE(PG8_SA(0, 0), a2, voffA);
      PG8_BAR; PG8_WAIT_L(0); PG8_MMA(1, 0, At, B0); PG8_BAR; PG8_SCHED;
      PG8_STAGE(PG8_SB(0, 1), b2 + hstep, voffB);
      PG8_WAIT_V(6); PG8_BAR; PG8_MMA(1, 1, At, B1); PG8_BAR;
      PG8_LDB(B0, 1, 0); PG8_SCHED; PG8_LDA(At, 1, 0); PG8_STAGE(PG8_SA(0, 1), a2 + hstep, voffA);
      PG8_WAIT_L(8); PG8_BAR; PG8_WAIT_L(0); PG8_MMA(0, 0, At, B0); PG8_BAR; PG8_SCHED;
      PG8_LDB(B1, 1, 1); PG8_STAGE(PG8_SB(1, 0), b3, voffB);
      PG8_BAR; PG8_WAIT_L(0); PG8_MMA(0, 1, At, B1); PG8_BAR;
      PG8_LDA(At, 1, 1); PG8_STAGE(PG8_SA(1, 0), a3, voffA);
      PG8_BAR; PG8_WAIT_L(0); PG8_MMA(1, 0, At, B0); PG8_BAR; PG8_SCHED;
      PG8_STAGE(PG8_SB(1, 1), b3 + hstep, voffB);
      PG8_WAIT_V(6); PG8_BAR; PG8_MMA(1, 1, At, B1); PG8_BAR;
    }
    E(acc, cur, wr, wc, fr, fq);
    if (!has_next) break;
#pragma unroll
    for (int a = 0; a < 2; ++a)
#pragma unroll
      for (int b = 0; b < 2; ++b)
#pragma unroll
        for (int m = 0; m < 4; ++m)
#pragma unroll
          for (int n = 0; n < 2; ++n) acc[a][b][m][n] = (f32x4){0.f, 0.f, 0.f, 0.f};
    cur = nxt; cA = nA; cB = nB; ++ui;
  }
  PG8_WAIT_V(0);
  if (wr == 0) PG8_BAR;
  PG8_BAR;
#undef PG8_SA
#undef PG8_SB
#undef PG8_STAGE
#undef PG8_LDA
#undef PG8_LDB
#undef PG8_MMA
#undef PG8_WAIT_V
#undef PG8_WAIT_L
#undef PG8_BAR
#undef PG8_SCHED
}
}

__host__ __device__ __forceinline__ int sigma_in(int c) {
  const int pn = c >> 8, t = c & 255, bj = t >> 7, wc = (t >> 5) & 3, u = t & 31;
  if (pn < 4) return pn * 256 + wc * 64 + (u < 8 ? bj * 8 + u : 16 + bj * 24 + (u - 8));
  if (pn == 6 || pn == 7) return pn * 256 + wc * 64 + bj * 32 + u;
  return c;
}
template <bool SIG>
__device__ __forceinline__ void transpose_tile(const float* __restrict__ W, int N, const float* __restrict__ g, bf16_t* __restrict__ Wt, int k0, int n0, float* tile  ) {
  const int tid = otid();
  { const int r = tid >> 4, c4 = (tid & 15) * 4;
    if (SIG) {
#pragma unroll
      for (int i = 0; i < 2; ++i)
#pragma unroll
        for (int jj = 0; jj < 4; ++jj) tile[(r + 32 * i) * 65 + c4 + jj] = W[(size_t)(k0 + r + 32 * i) * N + sigma_in(n0 + c4 + jj)];
    } else {
#pragma unroll
      for (int i = 0; i < 2; ++i) { const float4 v = *(const float4*)(W + (size_t)(k0 + r + 32 * i) * N + n0 + c4); float* tp = tile + (r + 32 * i) * 65 + c4; tp[0] = v.x; tp[1] = v.y; tp[2] = v.z; tp[3] = v.w; }
    } }
  __syncthreads();
  { const int i = tid >> 3, j8 = (tid & 7) * 8; const int sc = i;
    float v[8];
#pragma unroll
    for (int jj = 0; jj < 8; ++jj) v[jj] = tile[(j8 + jj) * 65 + sc] * (g ? g[k0 + j8 + jj] : 1.f);
    u32x4 w; w.x = cvt_pk_bf16(v[0], v[1]); w.y = cvt_pk_bf16(v[2], v[3]); w.z = cvt_pk_bf16(v[4], v[5]); w.w = cvt_pk_bf16(v[6], v[7]);
    *(u32x4*)(Wt + (size_t)(n0 + i) * 1024 + k0 + j8) = w; }
  __syncthreads();
}
template <bool SIG>
__device__ __forceinline__ void tile_load(const float* __restrict__ W, int N, int k0, int n0, int tid, float (&v)[8]) {
  const int r = tid >> 4, c4 = (tid & 15) * 4;
  if (SIG) {
#pragma unroll
    for (int i = 0; i < 2; ++i)
#pragma unroll
      for (int jj = 0; jj < 4; ++jj) v[4 * i + jj] = W[(size_t)(k0 + r + 32 * i) * N + sigma_in(n0 + c4 + jj)];
  } else {
#pragma unroll
    for (int i = 0; i < 2; ++i) { const float4 q = *(const float4*)(W + (size_t)(k0 + r + 32 * i) * N + n0 + c4); v[4 * i] = q.x; v[4 * i + 1] = q.y; v[4 * i + 2] = q.z; v[4 * i + 3] = q.w; }
  }
}
__device__ __forceinline__ void tile_stash(const float (&v)[8], int tid, float* tile  ) {
  const int r = tid >> 4, c4 = (tid & 15) * 4;
#pragma unroll
  for (int i = 0; i < 2; ++i)
#pragma unroll
    for (int jj = 0; jj < 4; ++jj) tile[(r + 32 * i) * 65 + c4 + jj] = v[4 * i + jj];
}
__device__ __forceinline__ void tile_emit(const float* __restrict__ g, bf16_t* __restrict__ Wt, int k0, int n0, int tid, const float* tile) {
  const int i = tid >> 3, j8 = (tid & 7) * 8;
  float v[8];
#pragma unroll
  for (int jj = 0; jj < 8; ++jj) v[jj] = tile[(j8 + jj) * 65 + i] * (g ? g[k0 + j8 + jj] : 1.f);
  u32x4 w; w.x = cvt_pk_bf16(v[0], v[1]); w.y = cvt_pk_bf16(v[2], v[3]); w.z = cvt_pk_bf16(v[4], v[5]); w.w = cvt_pk_bf16(v[6], v[7]);
  *(u32x4*)(Wt + (size_t)(n0 + i) * 1024 + k0 + j8) = w;
}

__device__ __forceinline__ void phase_prep(const Params& p, char* smem) {
  const int tid = otid(), wid = tid >> 6, lane = tid & 63, nb = gridDim.x, bid = blockIdx.x;
  const int gw = bid * 8 + wid, nw = nb * 8, gt = bid * 512 + tid, ntd = nb * 512;
  char* ws = p.ws;
  const bool six = (nb == 256); float tv[6][8];
  if (six) {
#pragma unroll
    for (int t = 0; t < 3; ++t) { const int it = bid + 256 * t; tile_load<true>(p.w_in, 3072, (it & 15) * 64, (it >> 4) * 64, tid, tv[t]); }
    { const int j = bid; tile_load<false>(p.w_out, 1024, (j & 15) * 64, (j >> 4) * 64, tid, tv[3]); }
#pragma unroll
    for (int t = 0; t < 2; ++t) { const int j = bid + 256 * t; tile_load<false>(p.wq, 2048, (j & 15) * 64, (j >> 4) * 64, tid, tv[4 + t]); }
  }
  { bf16_t* xb = (bf16_t*)(ws + OFF_XB); float* rstd0 = (float*)(ws + OFF_RSTD0);
    struct Rows { float4 v[4][4]; };
    auto ldrows = [&](int row0, Rows& R) {
#pragma unroll
      for (int r = 0; r < 4; ++r) { const float4* xr = (const float4*)(p.x + (size_t)(row0 + r) * 1024);
#pragma unroll
        for (int i = 0; i < 4; ++i) R.v[r][i] = xr[lane + 64 * i]; } };
    auto dorows = [&](int row0, const Rows& R) {
      float ss[4];
#pragma unroll
      for (int r = 0; r < 4; ++r) { float s_ = 0.f;
#pragma unroll
        for (int i = 0; i < 4; ++i) s_ += R.v[r][i].x * R.v[r][i].x + R.v[r][i].y * R.v[r][i].y + R.v[r][i].z * R.v[r][i].z + R.v[r][i].w * R.v[r][i].w;
        ss[r] = wave_sum(s_); }
#pragma unroll
      for (int r = 0; r < 4; ++r) {
#pragma unroll
        for (int i = 0; i < 4; ++i) { u32x2 w; w.x = cvt_pk_bf16(R.v[r][i].x, R.v[r][i].y); w.y = cvt_pk_bf16(R.v[r][i].z, R.v[r][i].w); *(u32x2*)(xb + (size_t)(row0 + r) * 1024 + (lane + 64 * i) * 4) = w; }
        if (lane == 0) rstd0[row0 + r] = rsqrtf(ss[r] * (1.f / 1024.f) + EPS); } };
    Rows RA, RB; const int st4 = nw * 4; int row0 = gw * 4;
    if (row0 < T) ldrows(row0, RA);
    for (; row0 < T; row0 += 2 * st4) {
      if (row0 + st4 < T) ldrows(row0 + st4, RB);
      dorows(row0, RA);
      if (row0 + st4 < T) { if (row0 + 2 * st4 < T) ldrows(row0 + 2 * st4, RA); dorows(row0 + st4, RB); }
    } }
  if (six) {
    float* tile = (float*)smem;
#pragma unroll
    for (int t = 0; t < 6; ++t) tile_stash(tv[t], tid, tile + t * 4160);
    __syncthreads();
#pragma unroll
    for (int t = 0; t < 3; ++t) { const int it = bid + 256 * t; tile_emit(p.attn_g, (bf16_t*)(ws + OFF_WIN), (it & 15) * 64, (it >> 4) * 64, tid, tile + t * 4160); }
    { const int j = bid; tile_emit(nullptr, (bf16_t*)(ws + OFF_WOUT), (j & 15) * 64, (j >> 4) * 64, tid, tile + 3 * 4160); }
#pragma unroll
    for (int t = 0; t < 2; ++t) { const int j = bid + 256 * t; tile_emit(p.ffn_g, (bf16_t*)(ws + OFF_WQ), (j & 15) * 64, (j >> 4) * 64, tid, tile + (4 + t) * 4160); }
    __syncthreads();
  } else
  { float* tile = (float*)smem;
    for (int it = bid; it < 1536; it += nb) {
      if (it < 768) transpose_tile<true>(p.w_in, 3072, p.attn_g, (bf16_t*)(ws + OFF_WIN), (it & 15) * 64, (it >> 4) * 64, tile);
      else if (it < 1024) { const int j = it - 768; transpose_tile<false>(p.w_out, 1024, nullptr, (bf16_t*)(ws + OFF_WOUT), (j & 15) * 64, (j >> 4) * 64, tile); }
      else { const int j = it - 1024; transpose_tile<false>(p.wq, 2048, p.ffn_g, (bf16_t*)(ws + OFF_WQ), (j & 15) * 64, (j >> 4) * 64, tile); }
    } }
  { bf16_t* kb = (bf16_t*)(ws + OFF_KEYS); for (int i = gt; i < 16 * 128 * 128; i += ntd) kb[i] = f2bf(p.keys[i]); }
  if (gt == 0) { float s1 = 0.f, s2 = 0.f; for (int d = 0; d < 64; ++d) { s1 += p.dlam[d] * p.dlam[64 + d]; s2 += p.dlam[128 + d] * p.dlam[192 + d]; }
    *(float*)(ws + OFF_LAM) = expf(s1) - expf(s2) + 0.2f; }
  { float* ssq1 = (float*)(ws + OFF_SSQ1); for (int i = gt; i < T; i += ntd) ssq1[i] = 0.f; if (gt < 64) { ((unsigned*)(ws + OFF_QHEAD))[gt] = 0u; ((unsigned*)(ws + OFF_KN))[gt] = 0u; } }
}

struct EpiInproj {
  static constexpr bool PERM = true;
  char* ws; const float* rstd0; unsigned* kn; float rsv[8];
  __device__ __forceinline__ void pre(const pg8::Unit& u, int wr, int fr) {
    const float* bp = rstd0 + u.pm * 256 + wr * 64 + fr;
#define PG8_RL(i, OFS) asm volatile("global_load_dword %0, %1, off offset:" #OFS : "=v"(rsv[i]) : "v"(bp) : "memory")
    PG8_RL(0, 0); PG8_RL(1, 64); PG8_RL(2, 128); PG8_RL(3, 192); PG8_RL(4, 512); PG8_RL(5, 576); PG8_RL(6, 640); PG8_RL(7, 704);
#undef PG8_RL
  }
  __device__ __forceinline__ static void st8(bf16_t* p, f32x4 a, f32x4 b) { u32x4 w; w.x = cvt_pk_bf16(a[0], a[1]); w.y = cvt_pk_bf16(a[2], a[3]); w.z = cvt_pk_bf16(b[0], b[1]); w.w = cvt_pk_bf16(b[2], b[3]); *(u32x4*)p = w; }
  __device__ __forceinline__ static void rot8(float pos, const float (&cf)[8], f32x4& a0, f32x4& a1, f32x4& b0, f32x4& b1) {
    f32x4 co0, si0, co1, si1;
#pragma unroll
    for (int i = 0; i < 4; ++i) { const float r0 = __builtin_amdgcn_fractf(pos * cf[i]), r1 = __builtin_amdgcn_fractf(pos * cf[4 + i]);
      co0[i] = __builtin_amdgcn_cosf(r0); si0[i] = __builtin_amdgcn_sinf(r0); co1[i] = __builtin_amdgcn_cosf(r1); si1[i] = __builtin_amdgcn_sinf(r1); }
    const f32x4 x0 = a0, x1 = a1, y0 = b0, y1 = b1;
    a0 = x0 * co0 - y0 * si0; a1 = x1 * co1 - y1 * si1; b0 = y0 * co0 + x0 * si0; b1 = y1 * co1 + x1 * si1;
  }
  __device__ __forceinline__ void operator()(const f32x4 (&acc)[2][2][4][2], const pg8::Unit& u, int wr, int wc, int fr, int fq) const {
    const int pn = u.pn;
    float cf[8];
    { const bool retn = pn >= 6; const float l2 = retn ? -13.287712379549449f / 31.f : -18.931568569324174f / 8.f;
      const int f0 = retn ? 8 * fq : 0;
#pragma unroll
      for (int i = 0; i < 8; ++i) cf[i] = __builtin_amdgcn_exp2f(l2 * (float)(f0 + i)) * 0.15915494309189535f; }
    float kmax = 0.f;
#pragma unroll
    for (int ai = 0; ai < 2; ++ai)
#pragma unroll
      for (int m = 0; m < 4; ++m) {
        const int row = u.pm * 256 + ai * 128 + wr * 64 + m * 16 + fr; const float rs = rsv[ai * 4 + m]; const float pos = (float)(row & (S - 1));
        f32x4 a0 = acc[ai][0][m][0] * rs, a1 = acc[ai][0][m][1] * rs, b0 = acc[ai][1][m][0] * rs, b1 = acc[ai][1][m][1] * rs;
        if (pn == 2 || pn == 3) { float ss = 0.f;
#pragma unroll
          for (int e = 0; e < 4; ++e) ss += a0[e] * a0[e] + a1[e] * a1[e] + b0[e] * b0[e] + b1[e] * b1[e];
          ss += __shfl_xor(ss, 16); ss += __shfl_xor(ss, 32); kmax = fmaxf(kmax, ss); }
        if (pn < 4) {
          bf16_t* dst = (bf16_t*)(ws + (pn < 2 ? OFF_QD : OFF_KD)) + (size_t)row * 512 + (pn & 1) * 256 + wc * 64;
          if (fq == 0) { rot8(pos, cf, a0, a1, b0, b1); st8(dst, a0, a1); st8(dst + 8, b0, b1); }
          else { st8(dst + 8 + 8 * fq, a0, a1); st8(dst + 32 + 8 * fq, b0, b1); }
        } else if (pn == 6 || pn == 7) {
          rot8(pos, cf, a0, a1, b0, b1);
          if (pn == 7) { a0 = a0 * 0.125f; a1 = a1 * 0.125f; b0 = b0 * 0.125f; b1 = b1 * 0.125f; }
          bf16_t* dst = (bf16_t*)(ws + (pn == 6 ? OFF_RQ : OFF_RK)) + (size_t)row * 256 + wc * 64;
          st8(dst + 8 * fq, a0, a1); st8(dst + 32 + 8 * fq, b0, b1);
        } else {
          bf16_t* base = (bf16_t*)(ws + (pn < 6 ? OFF_VD : pn < 10 ? OFF_RV : OFF_RG)); const int pb = pn < 6 ? 4 : pn < 10 ? 8 : 10;
          bf16_t* dst = base + (size_t)row * 512 + (pn - pb) * 256 + wc * 32 + 8 * fq;
          st8(dst, a0, a1); st8(dst + 128, b0, b1);
        }
      }
    if (pn == 2 || pn == 3) {
      kmax = wave_max(kmax) * 1.01f;
      if ((fr | fq) == 0) atomicMax(kn + ((u.pm * 256) >> 12) * 8 + (pn & 1) * 4 + wc, __float_as_uint(kmax)); }
  }
};

namespace att {
typedef short s16x4 __attribute__((ext_vector_type(4)));
typedef float f32x16 __attribute__((ext_vector_type(16)));
constexpr int KVBLK = 64, LDQ = 512, LDK = 512;
constexpr float SCALE = 0.125f, SHIFT = 20.f;
constexpr size_t SHM_V = KVBLK * 128 * 2, SHM_K = KVBLK * 128 * 2;
#define KSWZ(row, colB) ((row) * 256 + ((colB) ^ (((row) & 7) << 4)))
#define SBAR() __builtin_amdgcn_sched_barrier(0)
__device__ __forceinline__ int crow(int r, int hi) { return (r & 3) + 8 * (r >> 2) + 4 * hi; }
__device__ __forceinline__ bf16x8 ld8(const bf16_t* p) { return *reinterpret_cast<const bf16x8*>(p); }
__device__ __forceinline__ void partialSM(f32x16& p0, f32x16& p1) {
#pragma unroll
  for (int r = 0; r < 16; ++r) p0[r] = __builtin_amdgcn_exp2f(p0[r]);
}
__device__ __forceinline__ void finishSM(f32x16& p0, f32x16& p1, bf16x8& pa0, bf16x8& pa1, bf16x8& pa2, bf16x8& pa3, f32x2& l0, f32x2& l1) {
#pragma unroll
  for (int r = 0; r < 16; ++r) p1[r] = __builtin_amdgcn_exp2f(p1[r]);
#pragma unroll
  for (int r = 0; r < 16; r += 2) { l0 += (f32x2){p0[r], p0[r + 1]}; l1 += (f32x2){p1[r], p1[r + 1]}; }
#define PK4(P, BASE, OUT) do { u32x4 w = {cvt_pk_bf16(P[BASE + 0], P[BASE + 1]), cvt_pk_bf16(P[BASE + 2], P[BASE + 3]), cvt_pk_bf16(P[BASE + 4], P[BASE + 5]), cvt_pk_bf16(P[BASE + 6], P[BASE + 7])}; \
    OUT = *reinterpret_cast<bf16x8*>(&w); } while (0)
  PK4(p0, 0, pa0); PK4(p0, 8, pa1); PK4(p1, 0, pa2); PK4(p1, 8, pa3);
#undef PK4
}
__device__ __forceinline__ void qkt(f32x16& p0, f32x16& p1, const char* Ks, const bf16x8* qr, int r32, int hi, int map, const f32x16& mCv) {
#pragma unroll
  for (int d0 = 0; d0 < 4; ++d0) { const int cb = ((map * 4 + d0) * 16 + hi * 8) * 2;
    const bf16x8 b0 = *reinterpret_cast<const bf16x8*>(Ks + KSWZ(r32, cb));
    const bf16x8 b1 = *reinterpret_cast<const bf16x8*>(Ks + KSWZ(32 + r32, cb));
    if (d0 == 0) { p0 = __builtin_amdgcn_mfma_f32_32x32x16_bf16(b0, qr[0], mCv, 0, 0, 0); p1 = __builtin_amdgcn_mfma_f32_32x32x16_bf16(b1, qr[0], mCv, 0, 0, 0); }
    else { p0 = __builtin_amdgcn_mfma_f32_32x32x16_bf16(b0, qr[d0], p0, 0, 0, 0); p1 = __builtin_amdgcn_mfma_f32_32x32x16_bf16(b1, qr[d0], p1, 0, 0, 0); } }
}
__device__ __forceinline__ int v_st(int k, int c) { const int kk = (k & ~0xC) | ((k & 4) << 1) | ((k & 8) >> 1); return ((kk >> 3) * 4 + (c >> 5)) * 512 + ((kk & 7) * 32 + (c & 31)) * 2; }
__device__ __forceinline__ int v_stn(int k, int c) { return ((k >> 3) * 4 + (c >> 5)) * 512 + ((k & 7) * 32 + (c & 31)) * 2; }
__device__ __forceinline__ int v_rd_base(int lane) { return ((lane & 3) << 3) | (((lane >> 2) & 3) << 6) | (((lane >> 4) & 1) << 5) | (((lane >> 5) & 1) << 8); }
constexpr int v_rd_off(int d0, int ks, int half) { return d0 * 512 + ks * 4096 + half * 2048; }
template <int OFF> __device__ __forceinline__ s16x4 tr_read(int vb) {
  s16x4 r; asm volatile("ds_read_b64_tr_b16 %0, %1 offset:%2" : "=&v"(r) : "v"(vb), "i"(OFF) : "memory"); return r;
}
template <int D0> __device__ __forceinline__ void pv_one(f32x16& od, int vb, bf16x8 pa0, bf16x8 pa1, bf16x8 pa2, bf16x8 pa3) {
  const s16x4 l0 = tr_read<v_rd_off(D0, 0, 0)>(vb), h0 = tr_read<v_rd_off(D0, 0, 1)>(vb), l1 = tr_read<v_rd_off(D0, 1, 0)>(vb), h1 = tr_read<v_rd_off(D0, 1, 1)>(vb);
  const s16x4 l2 = tr_read<v_rd_off(D0, 2, 0)>(vb), h2 = tr_read<v_rd_off(D0, 2, 1)>(vb), l3 = tr_read<v_rd_off(D0, 3, 0)>(vb), h3 = tr_read<v_rd_off(D0, 3, 1)>(vb);
  asm volatile("s_waitcnt lgkmcnt(0)" ::: "memory"); SBAR();
#define PK(L, H) (bf16x8){L[0], L[1], L[2], L[3], H[0], H[1], H[2], H[3]}
  od = __builtin_amdgcn_mfma_f32_32x32x16_bf16(PK(l0, h0), pa0, od, 0, 0, 0);
  od = __builtin_amdgcn_mfma_f32_32x32x16_bf16(PK(l1, h1), pa1, od, 0, 0, 0);
  od = __builtin_amdgcn_mfma_f32_32x32x16_bf16(PK(l2, h2), pa2, od, 0, 0, 0);
  od = __builtin_amdgcn_mfma_f32_32x32x16_bf16(PK(l3, h3), pa3, od, 0, 0, 0);
#undef PK
}
__device__ __forceinline__ void pv_d0(f32x16* o, int vb, bf16x8 pa0, bf16x8 pa1, bf16x8 pa2, bf16x8 pa3) {
  pv_one<0>(o[0], vb, pa0, pa1, pa2, pa3); pv_one<1>(o[1], vb, pa0, pa1, pa2, pa3); pv_one<2>(o[2], vb, pa0, pa1, pa2, pa3); pv_one<3>(o[3], vb, pa0, pa1, pa2, pa3);
}
__device__ __forceinline__ void attn_item(const bf16_t* __restrict__ Qb, const bf16_t* __restrict__ Kh, const bf16_t* __restrict__ Vh, bf16_t* __restrict__ mixo,
                                          const float* __restrict__ dng, float lam, const float* __restrict__ kn2  , char* lds) {
  const int tid = otid(), wid = tid >> 6, lane = tid & 63, r32 = lane & 31, hi = lane >> 5, qsub = wid >> 1, map = wid & 1;
  char* V_lds = lds; char* K_lds = lds + 4 * SHM_V;
  f32x16 o[4] = {}; f32x2 l0 = {0.f, 0.f}, l1 = {0.f, 0.f}; bf16x8 qr[4];
  const bf16_t* Qw = Qb + (long)(qsub * 32 + r32) * LDQ + map * 64 + hi * 8;
#pragma unroll
  for (int d0 = 0; d0 < 4; ++d0) qr[d0] = ld8(Qw + d0 * 16);
  float mC;
  { float qn = 0.f;
#pragma unroll
    for (int d0 = 0; d0 < 4; ++d0)
#pragma unroll
      for (int e = 0; e < 8; ++e) { const float v = bf2f((bf16_t)qr[d0][e]); qn = fmaf(v, v, qn); }
    { auto rr = __builtin_amdgcn_permlane32_swap(__float_as_uint(qn), __float_as_uint(qn), false, false); qn = __uint_as_float(rr[0]) + __uint_as_float(rr[1]); }
    mC = -(SCALE * sqrtf(qn * kn2[map]) * 1.0001f - SHIFT) * 1.4426950408889634f; }
  { constexpr float C = SCALE * 1.4426950408889634f;
#pragma unroll
    for (int d0 = 0; d0 < 4; ++d0) { u32x4 w;
#pragma unroll
      for (int e = 0; e < 4; ++e) w[e] = cvt_pk_bf16(bf2f((bf16_t)qr[d0][2 * e]) * C, bf2f((bf16_t)qr[d0][2 * e + 1]) * C);
      qr[d0] = *reinterpret_cast<bf16x8*>(&w); } }
  f32x16 mCv;
#pragma unroll
  for (int r = 0; r < 16; ++r) mCv[r] = mC;
  const int vb0 = (int)(uintptr_t)V_lds + v_rd_base(lane);
  const int widu = __builtin_amdgcn_readfirstlane(wid);
  unsigned goV[2], goK[2];
#pragma unroll
  for (int i = 0; i < 2; ++i) { const int q = 2 * widu + i;
    const int keyV = 8 * (q >> 1) + ((lane & 31) >> 2), colV = 32 * (2 * (q & 1) + (lane >> 5)) + (lane & 3) * 8;
    goV[i] = (unsigned)(keyV * LDK + colV) * 2u;
    const int rowK = 4 * q + (lane >> 4), cbp = (lane & 15) * 16;
    goK[i] = (unsigned)(rowK * LDK * 2 + (cbp ^ ((rowK & 7) << 4))); }
  LAS char* ldsL = (LAS char*)lds + 2048 * widu;
#define DMA(slot, k0) do { const char* gv_ = (const char*)Vh + (size_t)(k0) * (LDK * 2); const char* gk_ = (const char*)Kh + (size_t)(k0) * (LDK * 2); \
    _Pragma("unroll") for (int i_ = 0; i_ < 2; ++i_) { \
      __builtin_amdgcn_global_load_lds((const unsigned*)(gv_ + goV[i_]), (LAS unsigned*)(ldsL + (slot) * (int)SHM_V + i_ * 1024), 16, 0, 0); \
      __builtin_amdgcn_global_load_lds((const unsigned*)(gk_ + goK[i_]), (LAS unsigned*)(ldsL + 4 * (int)SHM_V + (slot) * (int)SHM_K + i_ * 1024), 16, 0, 0); } } while (0)
#define BARV(n) do { asm volatile("s_waitcnt vmcnt(" #n ") lgkmcnt(0)" ::: "memory"); __builtin_amdgcn_s_barrier(); asm volatile("" ::: "memory"); } while (0)
  f32x16 pA0, pA1, pB0, pB1; bf16x8 pa0, pa1, pa2, pa3; constexpr int NT = S / KVBLK;
#define STEP(jj, RG, PC0, PC1, PP0, PP1) do {     \
    constexpr int rcur = (RG) * (int)SHM_K, rprv = (((RG) + 3) & 3) * (int)SHM_V; \
    SBAR(); qkt(PC0, PC1, K_lds + rcur, qr, r32, hi, map, mCv); \
    finishSM(PP0, PP1, pa0, pa1, pa2, pa3, l0, l1); SBAR(); \
    if ((jj) + 2 < NT) DMA(((RG) + 2) & 3, ((jj) + 2) * KVBLK); SBAR(); \
    pv_d0(o, vb0 + rprv, pa0, pa1, pa2, pa3); partialSM(PC0, PC1); \
    if ((jj) + 2 < NT) BARV(4); else BARV(0); } while (0)
  DMA(0, 0); DMA(1, KVBLK); BARV(4);
  qkt(pA0, pA1, K_lds, qr, r32, hi, map, mCv); partialSM(pA0, pA1);
  DMA(2, 2 * KVBLK); BARV(4);
  static_assert(NT % 4 == 0, "ring constants below assume NT % 4 == 0");
  for (int j = 1; j + 3 < NT; j += 4) {
    STEP(j, 1, pB0, pB1, pA0, pA1); STEP(j + 1, 2, pA0, pA1, pB0, pB1); STEP(j + 2, 3, pB0, pB1, pA0, pA1); STEP(j + 3, 0, pA0, pA1, pB0, pB1);
  }
  STEP(NT - 3, 1, pB0, pB1, pA0, pA1); STEP(NT - 2, 2, pA0, pA1, pB0, pB1); STEP(NT - 1, 3, pB0, pB1, pA0, pA1);
  finishSM(pB0, pB1, pa0, pa1, pa2, pa3, l0, l1); SBAR();
  pv_d0(o, vb0 + ((NT - 1) & 3) * (int)SHM_V, pa0, pa1, pa2, pa3);
#undef STEP
#undef DMA
#undef BARV
  float lsum = (l0.x + l0.y) + (l1.x + l1.y);
  { auto rr = __builtin_amdgcn_permlane32_swap(__float_as_uint(lsum), __float_as_uint(lsum), false, false); lsum = __uint_as_float(rr[0]) + __uint_as_float(rr[1]); }
  const float rli = lsum > 0.f ? __builtin_amdgcn_rcpf(lsum) : 0.f;
  __syncthreads();
  float* X = (float*)lds + qsub * 4096;
  if (map == 1) { const float f = rli * lam;
#pragma unroll
    for (int d0 = 0; d0 < 4; ++d0)
#pragma unroll
      for (int r = 0; r < 16; ++r) X[(d0 * 16 + r) * 64 + lane] = o[d0][r] * f;
  }
  __syncthreads();
  if (map == 0) {
    float ss = 0.f;
#pragma unroll
    for (int d0 = 0; d0 < 4; ++d0)
#pragma unroll
      for (int r = 0; r < 16; ++r) { const float v = o[d0][r] * rli - X[(d0 * 16 + r) * 64 + lane]; o[d0][r] = v; ss = fmaf(v, v, ss); }
    { auto rr = __builtin_amdgcn_permlane32_swap(__float_as_uint(ss), __float_as_uint(ss), false, false); ss = __uint_as_float(rr[0]) + __uint_as_float(rr[1]); }
    const float rs = rsqrtf(ss * (1.f / 128.f) + EPS) * 0.8f;
    bf16_t* rowp = mixo + (long)(qsub * 32 + r32) * 1024 + (hi ? 8 : 0);
#pragma unroll
    for (int d0 = 0; d0 < 4; ++d0)
#pragma unroll
      for (int kp = 0; kp < 2; ++kp) {
        const int k = d0 * 4 + 2 * kp;
        const f32x4 ga = *(const f32x4*)(dng + 8 * k + 4 * hi), gb = *(const f32x4*)(dng + 8 * (k + 1) + 4 * hi);
        unsigned ax = cvt_pk_bf16(o[d0][8 * kp + 0] * rs * ga[0], o[d0][8 * kp + 1] * rs * ga[1]), ay = cvt_pk_bf16(o[d0][8 * kp + 2] * rs * ga[2], o[d0][8 * kp + 3] * rs * ga[3]);
        unsigned bx = cvt_pk_bf16(o[d0][8 * kp + 4] * rs * gb[0], o[d0][8 * kp + 5] * rs * gb[1]), by = cvt_pk_bf16(o[d0][8 * kp + 6] * rs * gb[2], o[d0][8 * kp + 7] * rs * gb[3]);
        { auto r0 = __builtin_amdgcn_permlane32_swap(ax, bx, false, false); ax = r0[0]; bx = r0[1]; }
        { auto r1 = __builtin_amdgcn_permlane32_swap(ay, by, false, false); ay = r1[0]; by = r1[1]; }
        *(u32x4*)(rowp + 8 * k) = (u32x4){ax, ay, bx, by};
      }
  }
  __syncthreads();
}
}

__device__ __forceinline__ void phase_attn(const Params& p, char* lds) {
  const float lam = *(const float*)(p.ws + OFF_LAM);
  const bf16_t* Qd = (const bf16_t*)(p.ws + OFF_QD); const bf16_t* Kd = (const bf16_t*)(p.ws + OFF_KD); const bf16_t* Vd = (const bf16_t*)(p.ws + OFF_VD);
  bf16_t* mix = (bf16_t*)(p.ws + OFF_MIX);
  for (int u = blockIdx.x; u < 1024; u += gridDim.x) {
    const int xcd = u & 7, j = u >> 3, bh = (j >> 5) * 8 + xcd, qblk = j & 31, b = bh >> 2, h = bh & 3;
    const size_t t0 = (size_t)b * S;
    att::attn_item(Qd + (t0 + qblk * 128) * 512 + h * 128, Kd + t0 * 512 + h * 128, Vd + t0 * 512 + h * 128, mix + (t0 + qblk * 128) * 1024 + h * 128, p.dng, lam, (const float*)(p.ws + OFF_KN) + bh * 2, lds);
  }
}


namespace ret {
using att::f32x16; using att::s16x4; using att::crow; using att::v_st; using att::v_rd_base; using att::v_rd_off; using att::tr_read; using att::ld8;
constexpr float LOG2E = 1.4426950408889634f;
#define RKL(row, colB) ((row) * 128 + ((colB) ^ (((row) & 7) << 4)))
#define PKF(L, H) (bf16x8){L[0], L[1], L[2], L[3], H[0], H[1], H[2], H[3]}
__device__ __forceinline__ void stage_v(const bf16_t* __restrict__ Rv, size_t t0, int h, char* Vl) {
  const int tid = otid();
#pragma unroll
  for (int i = 0; i < 4; ++i) { const int q = tid + 512 * i, row = q >> 4, c8 = (q & 15) * 8;
    const bf16x8 v = ld8(Rv + (t0 + row) * 512 + h * 128 + c8);
    *(bf16x8*)(Vl + (row >> 6) * 16384 + v_st(row & 63, c8)) = v; }
}
struct TabRows { u32x4 v[4][4]; };
__device__ __forceinline__ void tab_fetch(const Params& p, int r0, int lane, TabRows& tr) {
  const float* src = (r0 < 16384 ? p.pu : p.pv) + (size_t)(r0 & 16383) * 1024 + lane * 16;
#pragma unroll
  for (int k = 0; k < 4; ++k)
#pragma unroll
    for (int i = 0; i < 4; ++i) asm volatile("global_load_dwordx4 %0, %1, off" : "=v"(tr.v[k][i]) : "v"(src + k * 1024 + 4 * i) : "memory");
}
__device__ __forceinline__ void tab_finish(const Params& p, int r0, int lane, const TabRows& tr) {
  unsigned char* U8 = (unsigned char*)(p.ws + OFF_U8); unsigned char* V8 = (unsigned char*)(p.ws + OFF_V8); float* sc = (float*)(p.ws + OFF_USC);
  const bool isU = r0 < 16384;
  float gv[16];
#pragma unroll
  for (int i = 0; i < 16; ++i) gv[i] = 1.f;
  if (isU) {
#pragma unroll
    for (int i = 0; i < 4; ++i) { const float4 g4 = *(const float4*)(p.ffn_g + lane * 16 + 4 * i); gv[4 * i] = g4.x; gv[4 * i + 1] = g4.y; gv[4 * i + 2] = g4.z; gv[4 * i + 3] = g4.w; } }
#pragma unroll
  for (int k = 0; k < 4; ++k) { const int r = r0 + k, e = r & 16383; float v[16];
#pragma unroll
    for (int i = 0; i < 16; ++i) v[i] = __uint_as_float(tr.v[k][i >> 2][i & 3]) * gv[i];
    float am = 0.f;
#pragma unroll
    for (int i = 0; i < 16; ++i) am = fmaxf(am, fabsf(v[i]));
    am = wave_max(am);
    const float scl = am > 0.f ? 127.f / am : 1.f;
    u32x4 w;
#pragma unroll
    for (int i = 0; i < 4; ++i) { const int q0 = __float2int_rn(v[4 * i] * scl), q1 = __float2int_rn(v[4 * i + 1] * scl), q2 = __float2int_rn(v[4 * i + 2] * scl), q3 = __float2int_rn(v[4 * i + 3] * scl);
      w[i] = (unsigned)(q0 & 255) | ((unsigned)(q1 & 255) << 8) | ((unsigned)(q2 & 255) << 16) | ((unsigned)q3 << 24); }
    *(u32x4*)((isU ? U8 : V8) + (size_t)(lane >> 3) * (16384 * 128) + (size_t)e * 128 + (lane & 7) * 16) = w;
    if (lane == 0) sc[r] = am > 0.f ? am * (1.f / 127.f) : 1.f; }
}
struct StIn { bf16x8 v[4], k[2]; };
__device__ __forceinline__ void state_fetch(const Params& p, int item, int tid, StIn& in) {
  const int c = item & 31, bh = item >> 5, h = bh & 3, b = bh >> 2; const size_t t0 = (size_t)b * S + c * 128;
  const bf16_t* Rk = (const bf16_t*)(p.ws + OFF_RK); const bf16_t* Rv = (const bf16_t*)(p.ws + OFF_RV);
#pragma unroll
  for (int i = 0; i < 4; ++i) { const int q = tid + 512 * i, row = q >> 4, c8 = (q & 15) * 8; in.v[i] = ld8(Rv + (t0 + row) * 512 + h * 128 + c8); }
#pragma unroll
  for (int i = 0; i < 2; ++i) { const int q = tid + 512 * i, row = q >> 3, c8 = (q & 7) * 8; in.k[i] = ld8(Rk + (t0 + row) * 256 + h * 64 + c8); }
}
__device__ __forceinline__ void phase_states(const Params& p, char* lds) {
  const int tid = otid(), wid = tid >> 6, lane = tid & 63, r32 = lane & 31, hi = lane >> 5;
  char* Vl = lds; char* Kl = lds + 32768;
  StIn in;
  if ((int)blockIdx.x < 1024) state_fetch(p, blockIdx.x, tid, in);
  for (int item = blockIdx.x; item < 1024; item += gridDim.x) {
    const int h = (item >> 5) & 3;
    const float lgf2 = -expf(p.rld[h]) * LOG2E, lgb2 = -expf(p.rld[4 + h]) * LOG2E;
#pragma unroll
    for (int i = 0; i < 4; ++i) { const int q = tid + 512 * i, row = q >> 4, c8 = (q & 15) * 8; *(bf16x8*)(Vl + (row >> 6) * 16384 + v_st(row & 63, c8)) = in.v[i]; }
#pragma unroll
    for (int i = 0; i < 2; ++i) { const int q = tid + 512 * i, row = q >> 3, c8 = (q & 7) * 8; const bf16x8 kv = in.k[i];
      const float df = __builtin_amdgcn_exp2f(lgf2 * (float)(127 - row)), db = __builtin_amdgcn_exp2f(lgb2 * (float)row);
      float f[8];
#pragma unroll
      for (int e = 0; e < 8; ++e) f[e] = bf2f((bf16_t)kv[e]);
      u32x4 wf, wb;
#pragma unroll
      for (int e = 0; e < 4; ++e) { wf[e] = cvt_pk_bf16(f[2 * e] * df, f[2 * e + 1] * df); wb[e] = cvt_pk_bf16(f[2 * e] * db, f[2 * e + 1] * db); }
      char* kt = Kl + (row >> 6) * 16384;
      *(u32x4*)(kt + v_st(row & 63, c8)) = wf; *(u32x4*)(kt + v_st(row & 63, 64 + c8)) = wb; }
    __syncthreads();
    TabRows tr; const int trow = (item * 8 + wid) * 4; tab_fetch(p, trow, lane, tr);
    if (item + (int)gridDim.x < 1024) state_fetch(p, item + gridDim.x, tid, in);
    const int d0a = wid >> 1;
    const int vbV = (int)(uintptr_t)Vl + v_rd_base(lane), vbK = (int)(uintptr_t)Kl + v_rd_base(lane);
    f32x16 acc[2] = {};
#pragma unroll
    for (int tt = 0; tt < 2; ++tt) {
#define ST_STEP(KS) do { \
      const s16x4 kl = tr_read<v_rd_off(0, KS, 0)>(vbK + tt * 16384 + d0a * 512), kh = tr_read<v_rd_off(0, KS, 1)>(vbK + tt * 16384 + d0a * 512); \
      const s16x4 a0l = tr_read<v_rd_off(0, KS, 0)>(vbV + tt * 16384 + ((wid & 1) * 2) * 512), a0h = tr_read<v_rd_off(0, KS, 1)>(vbV + tt * 16384 + ((wid & 1) * 2) * 512); \
      const s16x4 a1l = tr_read<v_rd_off(1, KS, 0)>(vbV + tt * 16384 + ((wid & 1) * 2) * 512), a1h = tr_read<v_rd_off(1, KS, 1)>(vbV + tt * 16384 + ((wid & 1) * 2) * 512); \
      asm volatile("s_waitcnt lgkmcnt(0)" ::: "memory"); __builtin_amdgcn_sched_barrier(0); \
      acc[0] = __builtin_amdgcn_mfma_f32_32x32x16_bf16(PKF(a0l, a0h), PKF(kl, kh), acc[0], 0, 0, 0); \
      acc[1] = __builtin_amdgcn_mfma_f32_32x32x16_bf16(PKF(a1l, a1h), PKF(kl, kh), acc[1], 0, 0, 0); } while (0)
      ST_STEP(0); ST_STEP(1); ST_STEP(2); ST_STEP(3);
#undef ST_STEP
    }
    asm volatile("s_waitcnt vmcnt(0)" : "+v"(tr.v[0][0]), "+v"(tr.v[0][1]), "+v"(tr.v[0][2]), "+v"(tr.v[0][3]), "+v"(tr.v[1][0]), "+v"(tr.v[1][1]), "+v"(tr.v[1][2]), "+v"(tr.v[1][3]),
                 "+v"(tr.v[2][0]), "+v"(tr.v[2][1]), "+v"(tr.v[2][2]), "+v"(tr.v[2][3]), "+v"(tr.v[3][0]), "+v"(tr.v[3][1]), "+v"(tr.v[3][2]), "+v"(tr.v[3][3]) :: "memory");
    tab_finish(p, trow, lane, tr);
    bf16_t* Kst = (bf16_t*)(p.ws + OFF_ST) + ((size_t)item * 2 + (d0a >> 1)) * 8192;
#pragma unroll
    for (int e = 0; e < 2; ++e)
#pragma unroll
      for (int r = 0; r < 16; ++r) Kst[(((wid & 1) * 2 + e) * 32 + crow(r, hi)) * 64 + (d0a & 1) * 32 + r32] = (bf16_t)(cvt_pk_bf16(acc[e][r], acc[e][r]) & 0xffffu);
    __syncthreads();
  }
}
__device__ __forceinline__ void states_item(const Params& p, int item, char* lds) {
  const int tid = otid(), wid = tid >> 6, lane = tid & 63, r32 = lane & 31, hi = lane >> 5;
  char* Vl = lds; char* Kl = lds + 32768;
  StIn in; state_fetch(p, item, tid, in);
  {
    const int h = (item >> 5) & 3;
    const float lgf2 = -expf(p.rld[h]) * LOG2E, lgb2 = -expf(p.rld[4 + h]) * LOG2E;
#pragma unroll
    for (int i = 0; i < 4; ++i) { const int q = tid + 512 * i, row = q >> 4, c8 = (q & 15) * 8; *(bf16x8*)(Vl + (row >> 6) * 16384 + v_st(row & 63, c8)) = in.v[i]; }
#pragma unroll
    for (int i = 0; i < 2; ++i) { const int q = tid + 512 * i, row = q >> 3, c8 = (q & 7) * 8; const bf16x8 kv = in.k[i];
      const float df = __builtin_amdgcn_exp2f(lgf2 * (float)(127 - row)), db = __builtin_amdgcn_exp2f(lgb2 * (float)row);
      float f[8];
#pragma unroll
      for (int e = 0; e < 8; ++e) f[e] = bf2f((bf16_t)kv[e]);
      u32x4 wf, wb;
#pragma unroll
      for (int e = 0; e < 4; ++e) { wf[e] = cvt_pk_bf16(f[2 * e] * df, f[2 * e + 1] * df); wb[e] = cvt_pk_bf16(f[2 * e] * db, f[2 * e + 1] * db); }
      char* kt = Kl + (row >> 6) * 16384;
      *(u32x4*)(kt + v_st(row & 63, c8)) = wf; *(u32x4*)(kt + v_st(row & 63, 64 + c8)) = wb; }
    __syncthreads();
    TabRows tr; const int trow = (item * 8 + wid) * 4; tab_fetch(p, trow, lane, tr);
    const int d0a = wid >> 1;
    const int vbV = (int)(uintptr_t)Vl + v_rd_base(lane), vbK = (int)(uintptr_t)Kl + v_rd_base(lane);
    f32x16 acc[2] = {};
#pragma unroll
    for (int tt = 0; tt < 2; ++tt) {
#define ST_STEP(KS) do { \
      const s16x4 kl = tr_read<v_rd_off(0, KS, 0)>(vbK + tt * 16384 + d0a * 512), kh = tr_read<v_rd_off(0, KS, 1)>(vbK + tt * 16384 + d0a * 512); \
      const s16x4 a0l = tr_read<v_rd_off(0, KS, 0)>(vbV + tt * 16384 + ((wid & 1) * 2) * 512), a0h = tr_read<v_rd_off(0, KS, 1)>(vbV + tt * 16384 + ((wid & 1) * 2) * 512); \
      const s16x4 a1l = tr_read<v_rd_off(1, KS, 0)>(vbV + tt * 16384 + ((wid & 1) * 2) * 512), a1h = tr_read<v_rd_off(1, KS, 1)>(vbV + tt * 16384 + ((wid & 1) * 2) * 512); \
      asm volatile("s_waitcnt lgkmcnt(0)" ::: "memory"); __builtin_amdgcn_sched_barrier(0); \
      acc[0] = __builtin_amdgcn_mfma_f32_32x32x16_bf16(PKF(a0l, a0h), PKF(kl, kh), acc[0], 0, 0, 0); \
      acc[1] = __builtin_amdgcn_mfma_f32_32x32x16_bf16(PKF(a1l, a1h), PKF(kl, kh), acc[1], 0, 0, 0); } while (0)
      ST_STEP(0); ST_STEP(1); ST_STEP(2); ST_STEP(3);
#undef ST_STEP
    }
    asm volatile("s_waitcnt vmcnt(0)" : "+v"(tr.v[0][0]), "+v"(tr.v[0][1]), "+v"(tr.v[0][2]), "+v"(tr.v[0][3]), "+v"(tr.v[1][0]), "+v"(tr.v[1][1]), "+v"(tr.v[1][2]), "+v"(tr.v[1][3]),
                 "+v"(tr.v[2][0]), "+v"(tr.v[2][1]), "+v"(tr.v[2][2]), "+v"(tr.v[2][3]), "+v"(tr.v[3][0]), "+v"(tr.v[3][1]), "+v"(tr.v[3][2]), "+v"(tr.v[3][3]) :: "memory");
    tab_finish(p, trow, lane, tr);
    bf16_t* Kst = (bf16_t*)(p.ws + OFF_ST) + ((size_t)item * 2 + (d0a >> 1)) * 8192;
#pragma unroll
    for (int e = 0; e < 2; ++e)
#pragma unroll
      for (int r = 0; r < 16; ++r) Kst[(((wid & 1) * 2 + e) * 32 + crow(r, hi)) * 64 + (d0a & 1) * 32 + r32] = (bf16_t)(cvt_pk_bf16(acc[e][r], acc[e][r]) & 0xffffu);
    __syncthreads();
  }
}
__device__ __forceinline__ void phase_scan(const Params& p) {
  const bf16_t* __restrict__ Kst = (const bf16_t*)(p.ws + OFF_ST); bf16_t* __restrict__ Sst = (bf16_t*)(p.ws + OFF_SST);
  for (int g = blockIdx.x * 512 + otid(); g < 32 * 2 * 8192; g += gridDim.x * 512) {
    const int e = g & 8191, dir = (g >> 13) & 1, bh = g >> 14, h = bh & 3;
    const float gC = __builtin_amdgcn_exp2f(-expf(p.rld[dir * 4 + h]) * LOG2E * 128.f);
    const size_t base = ((size_t)bh * 32 * 2 + dir) * 8192 + e;
    const long step = dir ? -16384 : 16384; const size_t first = dir ? base + 31 * 16384 : base;
    float k[32];
#pragma unroll
    for (int cc = 0; cc < 32; ++cc) k[cc] = bf2f(Kst[first + (long)cc * step]);
    float s = 0.f;
#pragma unroll
    for (int cc = 0; cc < 32; ++cc) { Sst[first + (long)cc * step] = f2bf(s); s = fmaf(gC, s, k[cc]); }
  }
}
struct OutIn { bf16x8 v[4], k[2], g[4]; };
__device__ __forceinline__ void out_fetch(const Params& p, int item, int tid, OutIn& in) {
  const int c = item & 31, bh = item >> 5, h = bh & 3, b = bh >> 2; const size_t t0 = (size_t)b * S + c * 128;
  const bf16_t* Rk = (const bf16_t*)(p.ws + OFF_RK); const bf16_t* Rv = (const bf16_t*)(p.ws + OFF_RV); const bf16_t* Rg = (const bf16_t*)(p.ws + OFF_RG);
#pragma unroll
  for (int i = 0; i < 4; ++i) { const int q = tid + 512 * i, row = q >> 4, c8 = (q & 15) * 8; in.v[i] = ld8(Rv + (t0 + row) * 512 + h * 128 + c8); in.g[i] = ld8(Rg + (t0 + row) * 512 + h * 128 + c8); }
#pragma unroll
  for (int i = 0; i < 2; ++i) { const int q = tid + 512 * i, row = q >> 3, c8 = (q & 7) * 8; in.k[i] = ld8(Rk + (t0 + row) * 256 + h * 64 + c8); }
}
__device__ __forceinline__ void phase_retout(const Params& p, char* lds) {
  const int tid = otid(), wid = tid >> 6, qsub = wid & 3, dvh = wid >> 2;
  const bf16_t* Rq = (const bf16_t*)(p.ws + OFF_RQ); bf16_t* mix = (bf16_t*)(p.ws + OFF_MIX);
  char* Vl = lds; char* Kl = lds + 32768; char* Gl = lds + 49152; float* St = (float*)(lds + 86016);
  float* Gn = St + 1024;
  { const int t_ = tid; Gn[t_] = p.rng_[t_]; }
  float* Dt = St + 512;
  char* SFl = lds + 92160;
  const int widu = __builtin_amdgcn_readfirstlane(wid);
#define RO_DMA_SF(it_, ln_) do { const char* gs_ = (const char*)((const bf16_t*)(p.ws + OFF_SST) + (size_t)(it_) * 2 * 8192); \
    _Pragma("unroll") for (int i_ = 0; i_ < 4; ++i_) { const int g_ = 4 * widu + i_; \
      __builtin_amdgcn_global_load_lds((const unsigned*)(gs_ + (unsigned)(g_ * 1024 + ((ln_) >> 3) * 128 + ((((ln_) & 7) ^ ((ln_) >> 3)) << 4))), (LAS unsigned*)((LAS char*)lds + 92160 + g_ * 1024), 16, 0, 0); } } while (0)
  { int ln0 = tid & 63; asm volatile("" : "+v"(ln0)); if ((int)blockIdx.x < 1024) RO_DMA_SF((int)blockIdx.x, ln0); }
  OutIn in; int hcur = -1;
  if ((int)blockIdx.x < 1024) out_fetch(p, blockIdx.x, tid, in);
  for (int item = blockIdx.x; item < 1024; item += gridDim.x) {
    int lane = tid & 63; asm volatile("" : "+v"(lane));
    const int r32 = lane & 31, hi = lane >> 5;
    const int c = item & 31, bh = item >> 5, h = bh & 3, b = bh >> 2; const size_t t0 = (size_t)b * S + c * 128;
    if (h != hcur) {
      hcur = h; const float lgf2 = -expf(p.rld[h]) * LOG2E, lgb2 = -expf(p.rld[4 + h]) * LOG2E;
      if (tid < 255) { const int d = tid - 127; Dt[tid] = __builtin_amdgcn_exp2f(d >= 0 ? lgf2 * (float)d : lgb2 * (float)(-d)); }
      else if (tid >= 256 && tid < 384) Dt[tid] = __builtin_amdgcn_exp2f(lgf2 * (float)(tid - 256 + 1));
      else if (tid >= 384) Dt[tid] = __builtin_amdgcn_exp2f(lgb2 * (float)(128 - (tid - 384))); }
    bf16x8 qr[4];
    { const bf16_t* Qw = Rq + (t0 + qsub * 32 + r32) * 256 + h * 64 + hi * 8;
#pragma unroll
      for (int d0 = 0; d0 < 4; ++d0) qr[d0] = ld8(Qw + d0 * 16); }
#pragma unroll
    for (int i = 0; i < 4; ++i) { const int q = tid + 512 * i, row = q >> 4, c8 = (q & 15) * 8;
      *(bf16x8*)(Vl + (row >> 6) * 16384 + att::v_stn(row & 63, c8)) = in.v[i]; *(bf16x8*)(Gl + row * 272 + c8 * 2) = in.g[i]; }
#pragma unroll
    for (int i = 0; i < 2; ++i) { const int q = tid + 512 * i, row = q >> 3, c8 = (q & 7) * 8; *(bf16x8*)(Kl + (row >> 6) * 8192 + RKL(row & 63, c8 * 2)) = in.k[i]; }
    asm volatile("s_waitcnt vmcnt(0)" ::: "memory"); __syncthreads();
    { const int nx = item + (int)gridDim.x; out_fetch(p, nx < 1024 ? nx : item, tid, in); }
    f32x16 o[2];
#pragma unroll
    for (int dir = 0; dir < 2; ++dir) {
      const float qd = Dt[256 + dir * 128 + qsub * 32 + r32];
#pragma unroll
      for (int j = 0; j < 2; ++j) { f32x16 tc = {};
#pragma unroll
        for (int ks = 0; ks < 4; ++ks) { const int srow = (dvh * 2 + j) * 32 + r32;
          const bf16x8 sfr = *reinterpret_cast<const bf16x8*>(SFl + dir * 16384 + srow * 128 + (((ks * 2 + hi) ^ (srow & 7)) << 4));
          tc = __builtin_amdgcn_mfma_f32_32x32x16_bf16(sfr, qr[ks], tc, 0, 0, 0); }
#pragma unroll
        for (int r = 0; r < 16; ++r) o[j][r] = dir == 0 ? qd * tc[r] : fmaf(qd, tc[r], o[j][r]); }
      __builtin_amdgcn_sched_barrier(0);
    }
    f32x16 pq[2][2];
#pragma unroll
    for (int half = 0; half < 2; ++half) {
      f32x16 p0 = {}, p1 = {};
      const char* Ks = Kl + half * 8192;
#pragma unroll
      for (int d0 = 0; d0 < 4; ++d0) { const int cb = (d0 * 16 + hi * 8) * 2;
        const bf16x8 b0 = *reinterpret_cast<const bf16x8*>(Ks + RKL(r32, cb));
        const bf16x8 b1 = *reinterpret_cast<const bf16x8*>(Ks + RKL(32 + r32, cb));
        p0 = __builtin_amdgcn_mfma_f32_32x32x16_bf16(b0, qr[d0], p0, 0, 0, 0);
        p1 = __builtin_amdgcn_mfma_f32_32x32x16_bf16(b1, qr[d0], p1, 0, 0, 0); }
      pq[half][0] = p0; pq[half][1] = p1; }
    bf16x8 pa[2][4];
#pragma unroll
    for (int half = 0; half < 2; ++half) {
      const int i = qsub * 32 + r32;
#pragma unroll
      for (int r = 0; r < 16; ++r) { const int j0 = half * 64 + crow(r, hi);
        pq[half][0][r] *= Dt[127 + i - j0]; pq[half][1][r] *= Dt[127 + i - j0 - 32]; }
#define PK4(P, BASE, OUT) do { u32x4 w = {cvt_pk_bf16(P[BASE + 0], P[BASE + 1]), cvt_pk_bf16(P[BASE + 2], P[BASE + 3]), cvt_pk_bf16(P[BASE + 4], P[BASE + 5]), cvt_pk_bf16(P[BASE + 6], P[BASE + 7])}; \
    OUT = *reinterpret_cast<bf16x8*>(&w); } while (0)
      PK4(pq[half][0], 0, pa[half][0]); PK4(pq[half][0], 8, pa[half][1]); PK4(pq[half][1], 0, pa[half][2]); PK4(pq[half][1], 8, pa[half][3]);
#undef PK4
    }
#pragma unroll
    for (int half = 0; half < 2; ++half) {
      const int vb = (int)(uintptr_t)Vl + half * 16384 + v_rd_base(lane);
      if (dvh == 0) { att::pv_one<0>(o[0], vb, pa[half][0], pa[half][1], pa[half][2], pa[half][3]); att::pv_one<1>(o[1], vb, pa[half][0], pa[half][1], pa[half][2], pa[half][3]); }
      else          { att::pv_one<2>(o[0], vb, pa[half][0], pa[half][1], pa[half][2], pa[half][3]); att::pv_one<3>(o[1], vb, pa[half][0], pa[half][1], pa[half][2], pa[half][3]); }
    }
    __builtin_amdgcn_sched_barrier(0);
    float s1 = 0.f, s2 = 0.f;
#pragma unroll
    for (int j = 0; j < 2; ++j)
#pragma unroll
      for (int r = 0; r < 16; ++r) { s1 += o[j][r]; s2 = fmaf(o[j][r], o[j][r], s2); }
    { auto ra = __builtin_amdgcn_permlane32_swap(__float_as_uint(s1), __float_as_uint(s1), false, false); s1 = __uint_as_float(ra[0]) + __uint_as_float(ra[1]);
      auto rb = __builtin_amdgcn_permlane32_swap(__float_as_uint(s2), __float_as_uint(s2), false, false); s2 = __uint_as_float(rb[0]) + __uint_as_float(rb[1]); }
    if (hi == 0) *(f32x2*)(St + (wid * 32 + r32) * 2) = (f32x2){s1, s2};
    __syncthreads();
    __builtin_amdgcn_sched_barrier(0);
    if (item + (int)gridDim.x < 1024) RO_DMA_SF(item + (int)gridDim.x, lane);
    { const f32x2 ot = *(const f32x2*)(St + ((wid ^ 4) * 32 + r32) * 2);
      const float mu = (s1 + ot.x) * (1.f / 128.f), var = (s2 + ot.y) * (1.f / 128.f) - mu * mu; const float rs = rsqrtf(fmaxf(var, 0.f) + EPS);
      const int row = qsub * 32 + r32;
      bf16_t* rowp = mix + (t0 + row) * 1024 + 512 + h * 128 + dvh * 64 + (hi ? 8 : 0);
      const char* grow = Gl + row * 272 + (dvh * 64 + 4 * hi) * 2;
      const float* gn = Gn + h * 128 + dvh * 64 + 4 * hi;
#pragma unroll
      for (int j = 0; j < 2; ++j)
#pragma unroll
        for (int kp = 0; kp < 2; ++kp) {
          const int k = j * 4 + 2 * kp; unsigned pk[4];
#pragma unroll
          for (int g2 = 0; g2 < 2; ++g2) { const u32x2 gw = *(const u32x2*)(grow + (k + g2) * 16); const f32x4 gv = *(const f32x4*)(gn + 8 * (k + g2));
            const float gt[4] = {__uint_as_float(gw.x << 16), __uint_as_float(gw.x & 0xffff0000u), __uint_as_float(gw.y << 16), __uint_as_float(gw.y & 0xffff0000u)};
            float ov[4];
#pragma unroll
            for (int e = 0; e < 4; ++e) { const float sg = gt[e] * __builtin_amdgcn_rcpf(1.f + __expf(-gt[e])); ov[e] = sg * (o[j][8 * kp + 4 * g2 + e] - mu) * rs * gv[e]; }
            pk[2 * g2] = cvt_pk_bf16(ov[0], ov[1]); pk[2 * g2 + 1] = cvt_pk_bf16(ov[2], ov[3]); }
          { auto r0 = __builtin_amdgcn_permlane32_swap(pk[0], pk[2], false, false); pk[0] = r0[0]; pk[2] = r0[1]; }
          { auto r1 = __builtin_amdgcn_permlane32_swap(pk[1], pk[3], false, false); pk[1] = r1[0]; pk[3] = r1[1]; }
          *(u32x4*)(rowp + 8 * k) = (u32x4){pk[0], pk[1], pk[2], pk[3]};
        } }
    asm volatile("s_waitcnt lgkmcnt(0)" ::: "memory"); __builtin_amdgcn_s_barrier(); asm volatile("" ::: "memory");
  }
}
#undef RO_DMA_SF
}

template <int HALF> __device__ __forceinline__ void phase_attn_host(const Params& p, char* lds) {
  const float lam = *(const float*)(p.ws + OFF_LAM);
  const bf16_t* Qd = (const bf16_t*)(p.ws + OFF_QD); const bf16_t* Kd = (const bf16_t*)(p.ws + OFF_KD); const bf16_t* Vd = (const bf16_t*)(p.ws + OFF_VD);
  bf16_t* mix = (bf16_t*)(p.ws + OFF_MIX);
  const int nit = (1024 - (int)blockIdx.x + (int)gridDim.x - 1) / (int)gridDim.x, n0 = nit / 2;
  const int kb = HALF ? n0 : 0, ke = HALF ? nit : n0, pos = ((int)blockIdx.x >> 3) % (ke - kb + 1);
  auto hosted = [&]() { if (HALF == 0) ret::phase_states(p, lds); else ret::phase_retout(p, lds); };
  for (int k = kb; k < ke; ++k) {
    if (k - kb == pos) hosted();
    const int u = (int)blockIdx.x + k * (int)gridDim.x;
    const int xcd = u & 7, j = u >> 3, bh = (j >> 5) * 8 + xcd, qblk = j & 31, b = bh >> 2, h = bh & 3;
    const size_t t0 = (size_t)b * S;
    att::attn_item(Qd + (t0 + qblk * 128) * 512 + h * 128, Kd + t0 * 512 + h * 128, Vd + t0 * 512 + h * 128, mix + (t0 + qblk * 128) * 1024 + h * 128, p.dng, lam, (const float*)(p.ws + OFF_KN) + bh * 2, lds);
  }
  if (pos == ke - kb) hosted();
}


struct EpiOutproj {
  static constexpr bool PERM = true;
  const bf16_t* xb; bf16_t* x1b; float* ssq;
  __device__ __forceinline__ void pre(const pg8::Unit&, int, int) {}
  __device__ __forceinline__ void operator()(const f32x4 (&acc)[2][2][4][2], const pg8::Unit& u, int wr, int wc, int fr, int fq) const {
#pragma unroll
    for (int ai = 0; ai < 2; ++ai) {
      u32x4 xv[4][2];
#pragma unroll
      for (int m = 0; m < 4; ++m)
#pragma unroll
        for (int bj = 0; bj < 2; ++bj) xv[m][bj] = *(const u32x4*)(xb + (size_t)(u.pm * 256 + ai * 128 + wr * 64 + m * 16 + fr) * 1024 + u.pn * 256 + bj * 128 + wc * 32 + 8 * fq);
      __builtin_amdgcn_sched_barrier(0);
#pragma unroll
      for (int m = 0; m < 4; ++m) {
        const int row = u.pm * 256 + ai * 128 + wr * 64 + m * 16 + fr; float ss = 0.f;
#pragma unroll
        for (int bj = 0; bj < 2; ++bj) {
          const size_t off = (size_t)row * 1024 + u.pn * 256 + bj * 128 + wc * 32 + 8 * fq;
          const u32x4 xw = xv[m][bj];
          const f32x4 v0 = (f32x4){__uint_as_float(xw.x << 16), __uint_as_float(xw.x & 0xffff0000u), __uint_as_float(xw.y << 16), __uint_as_float(xw.y & 0xffff0000u)} + acc[ai][bj][m][0];
          const f32x4 v1 = (f32x4){__uint_as_float(xw.z << 16), __uint_as_float(xw.z & 0xffff0000u), __uint_as_float(xw.w << 16), __uint_as_float(xw.w & 0xffff0000u)} + acc[ai][bj][m][1];
          u32x4 w; w.x = cvt_pk_bf16(v0[0], v0[1]); w.y = cvt_pk_bf16(v0[2], v0[3]); w.z = cvt_pk_bf16(v1[0], v1[1]); w.w = cvt_pk_bf16(v1[2], v1[3]); *(u32x4*)(x1b + off) = w;
          ss += v0[0] * v0[0] + v0[1] * v0[1] + v0[2] * v0[2] + v0[3] * v0[3] + v1[0] * v1[0] + v1[1] * v1[1] + v1[2] * v1[2] + v1[3] * v1[3];
        }
        ss += __shfl_xor(ss, 16); ss += __shfl_xor(ss, 32);
        if (fq == 0) unsafeAtomicAdd(ssq + row, ss);
      }
      __builtin_amdgcn_sched_barrier(0);
    }
  }
};
struct EpiQ {
  static constexpr bool PERM = true;
  const float* ssq; bf16_t* q; float rsv[8];
  __device__ __forceinline__ void pre(const pg8::Unit& u, int wr, int fr) {
    const float* bp = ssq + u.pm * 256 + wr * 64 + fr;
#define PG8_RL(i, OFS) asm volatile("global_load_dword %0, %1, off offset:" #OFS : "=v"(rsv[i]) : "v"(bp) : "memory")
    PG8_RL(0, 0); PG8_RL(1, 64); PG8_RL(2, 128); PG8_RL(3, 192); PG8_RL(4, 512); PG8_RL(5, 576); PG8_RL(6, 640); PG8_RL(7, 704);
#undef PG8_RL
  }
  __device__ __forceinline__ void operator()(const f32x4 (&acc)[2][2][4][2], const pg8::Unit& u, int wr, int wc, int fr, int fq) const {
#pragma unroll
    for (int ai = 0; ai < 2; ++ai)
#pragma unroll
      for (int m = 0; m < 4; ++m) {
        const int row = u.pm * 256 + ai * 128 + wr * 64 + m * 16 + fr; const float rs = rsqrtf(rsv[ai * 4 + m] * (1.f / 1024.f) + EPS);
#pragma unroll
        for (int bj = 0; bj < 2; ++bj) {
          const f32x4 v0 = acc[ai][bj][m][0] * rs, v1 = acc[ai][bj][m][1] * rs;
          u32x4 w; w.x = cvt_pk_bf16(v0[0], v0[1]); w.y = cvt_pk_bf16(v0[2], v0[3]); w.z = cvt_pk_bf16(v1[0], v1[1]); w.w = cvt_pk_bf16(v1[2], v1[3]);
          *(u32x4*)(q + (size_t)row * 2048 + u.pn * 256 + bj * 128 + wc * 32 + 8 * fq) = w;
        }
      }
  }
};


namespace peer {
constexpr int TCH = 256, NCH = T / TCH;
__device__ __forceinline__ unsigned xcc_id() { return (unsigned)__builtin_amdgcn_s_getreg((3 << 11) | 20) & 0xFu; }
__device__ __forceinline__ float shx(float v, int m) { return __shfl_xor(v, m); }
template <int M2, int M1, int M0>
__device__ __forceinline__ void reduce16(const float (&a)[16], int lane, float& r0, float& r1) {
  const bool b2 = lane & M2, b1 = lane & M1, b0 = lane & M0;
  float b[8], c[4];
#pragma unroll
  for (int k = 0; k < 8; ++k) { const float mine = b2 ? a[k + 8] : a[k], send = b2 ? a[k] : a[k + 8]; b[k] = mine + shx(send, M2); }
#pragma unroll
  for (int k = 0; k < 4; ++k) { const float mine = b1 ? b[k + 4] : b[k], send = b1 ? b[k] : b[k + 4]; c[k] = mine + shx(send, M1); }
  { const float mine = b0 ? c[2] : c[0], send = b0 ? c[0] : c[2]; r0 = mine + shx(send, M0); }
  { const float mine = b0 ? c[3] : c[1], send = b0 ? c[1] : c[3]; r1 = mine + shx(send, M0); }
}
template <int M2, int M1, int M0>
__device__ __forceinline__ void reduce16i(const int (&a)[16], int lane, int& r0, int& r1) {
  const bool b2 = lane & M2, b1 = lane & M1, b0 = lane & M0;
  int b[8], c[4];
#pragma unroll
  for (int k = 0; k < 8; ++k) { const int mine = b2 ? a[k + 8] : a[k], send = b2 ? a[k] : a[k + 8]; b[k] = mine + __shfl_xor(send, M2); }
#pragma unroll
  for (int k = 0; k < 4; ++k) { const int mine = b1 ? b[k + 4] : b[k], send = b1 ? b[k] : b[k + 4]; c[k] = mine + __shfl_xor(send, M1); }
  { const int mine = b0 ? c[2] : c[0], send = b0 ? c[0] : c[2]; r0 = mine + __shfl_xor(send, M0); }
  { const int mine = b0 ? c[3] : c[1], send = b0 ? c[1] : c[3]; r1 = mine + __shfl_xor(send, M0); }
}
constexpr float XQ_CLAMP = 6.f;
struct TokE { u32x4 e[2]; };
template <bool UP> struct TokD { u32x4 raw[16]; u32x4 aux; bf16x8 x0, x1; float rs; unsigned xr; };
__device__ __forceinline__ void tok_ids(const Params& p, int t, int lane, TokE& in) {
  const u32x4* ep = (const u32x4*)((const unsigned short*)(p.ws + OFF_EID) + (size_t)t * 128 + (lane >> 3) * 16);
  in.e[0] = ep[0]; in.e[1] = ep[1];
}
template <bool UP> __device__ __forceinline__ void tok_gather(const Params& p, const unsigned char* base, int slab, int t, int lane, const TokE& in, TokD<UP>& d) {
#pragma unroll
  for (int i = 0; i < 16; ++i) { const unsigned w = in.e[i >> 3][(i >> 1) & 3]; d.raw[i] = *(const u32x4*)(base + (size_t)((i & 1) ? (w >> 16) : (w & 0xffffu)) * 128); }
  if (UP) { d.aux = *(const u32x4*)((const unsigned char*)(p.ws + OFF_WQ8) + (size_t)t * 128 + (lane >> 3) * 16);
    d.xr = *(const unsigned*)((const bf16_t*)(p.ws + OFF_X1B) + (size_t)t * 1024 + slab * 128 + (lane & 7) * 16 + 2 * (lane >> 3)); }
  else { const bf16_t* xp = (const bf16_t*)(p.ws + OFF_X1B) + (size_t)t * 1024 + slab * 128 + (lane & 7) * 16; d.x0 = *(const bf16x8*)xp; d.x1 = *(const bf16x8*)(xp + 8); d.rs = ((const float*)(p.ws + OFF_SSQ1))[t]; }
}
__device__ __forceinline__ void down_dots(const Params& p, int lane, const TokD<false>& d, int& r0, int& r1) {
  int xq[4];
  { const float rs = rsqrtf(d.rs * (1.f / 1024.f) + EPS) * (127.f / XQ_CLAMP); int q[16];
#pragma unroll
    for (int k = 0; k < 8; ++k) { q[k] = __float2int_rn(fminf(fmaxf(bf2f((bf16_t)d.x0[k]) * rs, -127.f), 127.f)); q[8 + k] = __float2int_rn(fminf(fmaxf(bf2f((bf16_t)d.x1[k]) * rs, -127.f), 127.f)); }
#pragma unroll
    for (int i = 0; i < 4; ++i) xq[i] = (int)((unsigned)(q[4 * i] & 255) | ((unsigned)(q[4 * i + 1] & 255) << 8) | ((unsigned)(q[4 * i + 2] & 255) << 16) | ((unsigned)q[4 * i + 3] << 24)); }
  int acc[16];
#pragma unroll
  for (int i = 0; i < 16; ++i) { int a = 0;
#pragma unroll
    for (int w = 0; w < 4; ++w) a = __builtin_amdgcn_sdot4((int)d.raw[i][w], xq[w], a, false);
    acc[i] = a; }
  reduce16i<4, 2, 1>(acc, lane, r0, r1);
}
__device__ __forceinline__ void down_dots_q(int lane, const TokD<false>& d, int& r0, int& r1) {
  int acc[16];
#pragma unroll
  for (int i = 0; i < 16; ++i) { int a = 0;
#pragma unroll
    for (int w = 0; w < 4; ++w) a = __builtin_amdgcn_sdot4((int)d.raw[i][w], (int)d.aux[w], a, false);
    acc[i] = a; }
  reduce16i<4, 2, 1>(acc, lane, r0, r1);
}
__device__ __forceinline__ void down_compute(const Params& p, int slab, int t, int lane, const TokD<false>& d) {
  const int g = lane >> 3, c = lane & 7; int r0, r1; down_dots(p, lane, d, r0, r1);
  *(unsigned*)((bf16_t*)(p.ws + OFF_PART) + ((size_t)slab * T + t) * 128 + 16 * g + 2 * c) = cvt_pk_bf16((float)r0 * (XQ_CLAMP / 127.f), (float)r1 * (XQ_CLAMP / 127.f));
}
__device__ __forceinline__ void up_dots(int lane, const TokD<true>& d, int& r0, int& r1) {
  int o[16];
#pragma unroll
  for (int k = 0; k < 16; ++k) o[k] = 0;
#pragma unroll
  for (int a = 0; a < 4; ++a)
#pragma unroll
    for (int w = 0; w < 4; ++w) {
      const unsigned r0 = d.raw[4 * a][w], r1 = d.raw[4 * a + 1][w], r2 = d.raw[4 * a + 2][w], r3 = d.raw[4 * a + 3][w];
      const unsigned lo01 = __builtin_amdgcn_perm(r1, r0, 0x05010400u), hi01 = __builtin_amdgcn_perm(r1, r0, 0x07030602u);
      const unsigned lo23 = __builtin_amdgcn_perm(r3, r2, 0x05010400u), hi23 = __builtin_amdgcn_perm(r3, r2, 0x07030602u);
      const unsigned c0 = __builtin_amdgcn_perm(lo23, lo01, 0x05040100u), c1 = __builtin_amdgcn_perm(lo23, lo01, 0x07060302u);
      const unsigned c2 = __builtin_amdgcn_perm(hi23, hi01, 0x05040100u), c3 = __builtin_amdgcn_perm(hi23, hi01, 0x07060302u);
      o[4 * w] = __builtin_amdgcn_sdot4((int)c0, (int)d.aux[a], o[4 * w], false); o[4 * w + 1] = __builtin_amdgcn_sdot4((int)c1, (int)d.aux[a], o[4 * w + 1], false);
      o[4 * w + 2] = __builtin_amdgcn_sdot4((int)c2, (int)d.aux[a], o[4 * w + 2], false); o[4 * w + 3] = __builtin_amdgcn_sdot4((int)c3, (int)d.aux[a], o[4 * w + 3], false);
    }
  reduce16i<32, 16, 8>(o, lane, r0, r1);
}
__device__ __forceinline__ void up_compute(const Params& p, int slab, int t, int lane, const TokD<true>& d) {
  const int g = lane >> 3, c = lane & 7; int r0, r1; up_dots(lane, d, r0, r1);
  const float ws = ((const float*)(p.ws + OFF_WSC))[t];
  *(unsigned*)((bf16_t*)(p.ws + OFF_PO) + (size_t)t * 1024 + slab * 128 + c * 16 + 2 * g) = cvt_pk_bf16(fmaf((float)r0, ws, __uint_as_float(d.xr << 16)), fmaf((float)r1, ws, __uint_as_float(d.xr & 0xffff0000u)));
}
template <bool UP, int NTOK>
__device__ __forceinline__ void gather_wave(const Params& p, int slab, int t0, int lane) {
  const unsigned char* base = (const unsigned char*)(p.ws + (UP ? OFF_V8 : OFF_U8)) + (size_t)slab * (16384 * 128) + (lane & 7) * 16;
  TokE eA, eB; TokD<UP> dA, dB;
  tok_ids(p, t0, lane, eA); tok_ids(p, t0 + 1, lane, eB);
  tok_gather<UP>(p, base, slab, t0, lane, eA, dA);
  for (int k = 0; k < NTOK; k += 2) {
    tok_gather<UP>(p, base, slab, t0 + k + 1, lane, eB, dB);
    tok_ids(p, (k + 2 < NTOK) ? t0 + k + 2 : t0, lane, eA);
    if constexpr (UP) up_compute(p, slab, t0 + k, lane, dA); else down_compute(p, slab, t0 + k, lane, dA);
    if (k + 2 < NTOK) tok_gather<UP>(p, base, slab, t0 + k + 2, lane, eA, dA);
    tok_ids(p, (k + 3 < NTOK) ? t0 + k + 3 : t0, lane, eB);
    if constexpr (UP) up_compute(p, slab, t0 + k + 1, lane, dB); else down_compute(p, slab, t0 + k + 1, lane, dB);
  }
}
template <bool UP>
__device__ __forceinline__ void phase_gather(const Params& p, char* lds, int qoff = 0) {
  const int tid = otid(), wid = tid >> 6, lane = tid & 63;
  unsigned* qh = (unsigned*)(p.ws + OFF_QHEAD) + (UP ? 8 : 0) + qoff;
  int* bc = (int*)lds;
  const int my = (int)(xcc_id() & 7u);
  for (int pass = 0; pass < 8; ++pass) {
    const int slab = (my + pass) & 7;
    for (;;) {
      if (tid == 0) bc[0] = (int)atomicAdd(qh + slab, 1u);
      __syncthreads();
      const int ch = bc[0];
      __syncthreads();
      if (ch >= NCH) break;
      gather_wave<UP, TCH / 8>(p, slab, ch * TCH + wid * (TCH / 8), lane);
    }
  }
}
__device__ __forceinline__ void phase_finish(const Params& p) {
  const bf16_t* part = (const bf16_t*)(p.ws + OFF_PART); const unsigned short* eid = (const unsigned short*)(p.ws + OFF_EID); const float* gate = (const float*)(p.ws + OFF_GATE);
  const float* sc = (const float*)(p.ws + OFF_USC);
  const int tid_ = otid(), wid = tid_ >> 6, lane = tid_ & 63;
  for (int tb = (blockIdx.x * 8 + wid) * 4; tb < T; tb += gridDim.x * 32) {
    unsigned pw[4][8]; u32x2 gt[4];
#pragma unroll
    for (int r = 0; r < 4; ++r) { const size_t i = (size_t)(tb + r) * 128 + 2 * lane; gt[r] = *(const u32x2*)(gate + i);
#pragma unroll
      for (int sl = 0; sl < 8; ++sl) pw[r][sl] = *(const unsigned*)(part + (size_t)sl * T * 128 + i); }
#pragma unroll
    for (int r = 0; r < 4; ++r) { const size_t i = (size_t)(tb + r) * 128 + 2 * lane;
      float s0 = 0.f, s1 = 0.f;
#pragma unroll
      for (int sl = 0; sl < 8; ++sl) { s0 += __uint_as_float(pw[r][sl] << 16); s1 += __uint_as_float(pw[r][sl] & 0xffff0000u); }
      s0 *= __uint_as_float(gt[r].x & 0xffff0000u); s1 *= __uint_as_float(gt[r].y & 0xffff0000u);
      const float h0 = __uint_as_float(gt[r].x << 16) * 0.5f * s0 * (1.f + erff(s0 * 0.70710678118654752f));
      const float h1 = __uint_as_float(gt[r].y << 16) * 0.5f * s1 * (1.f + erff(s1 * 0.70710678118654752f));
      const float am = wave_max(fmaxf(fabsf(h0), fabsf(h1)));
      const float inv = am > 0.f ? 127.f / am : 0.f;
      const int q0 = __float2int_rn(h0 * inv), q1 = __float2int_rn(h1 * inv);
      *(unsigned short*)((unsigned char*)(p.ws + OFF_WQ8) + i) = (unsigned short)((q0 & 255) | ((q1 & 255) << 8));
      if (lane == 0) ((float*)(p.ws + OFF_WSC))[tb + r] = am * (1.f / 127.f); }
  }
}
__device__ __forceinline__ void phase_final(const Params& p) {
  const int tid_ = otid(), wid = tid_ >> 6, lane = tid_ & 63; const bf16_t* po = (const bf16_t*)(p.ws + OFF_PO);
  struct Rows { u32x2 pw[4][4]; };
  auto ldrows = [&](int t0, Rows& R) {
#pragma unroll
    for (int r = 0; r < 4; ++r)
#pragma unroll
      for (int i = 0; i < 4; ++i) R.pw[r][i] = *(const u32x2*)(po + (size_t)(t0 + r) * 1024 + (lane + 64 * i) * 4); };
  auto dorows = [&](int t0, Rows& R) {
    float ss[4];
#pragma unroll
    for (int r = 0; r < 4; ++r) { float s_ = 0.f;
#pragma unroll
      for (int i = 0; i < 4; ++i) { const float a = __uint_as_float(R.pw[r][i].x << 16), b = __uint_as_float(R.pw[r][i].x & 0xffff0000u), c = __uint_as_float(R.pw[r][i].y << 16), d = __uint_as_float(R.pw[r][i].y & 0xffff0000u);
        s_ += a * a + b * b + c * c + d * d; }
      ss[r] = rsqrtf(wave_sum(s_) * (1.f / 1024.f) + EPS); }
#pragma unroll
    for (int i = 0; i < 4; ++i) { const f32x4 g4 = *(const f32x4*)(p.fg + (lane + 64 * i) * 4);
#pragma unroll
      for (int r = 0; r < 4; ++r) { const f32x4 v = (f32x4){__uint_as_float(R.pw[r][i].x << 16), __uint_as_float(R.pw[r][i].x & 0xffff0000u), __uint_as_float(R.pw[r][i].y << 16), __uint_as_float(R.pw[r][i].y & 0xffff0000u)};
        ((f32x4*)(p.out + (size_t)(t0 + r) * 1024))[lane + 64 * i] = v * g4 * ss[r]; } } };
  Rows RA, RB; const int st2 = gridDim.x * 32; int t0 = (blockIdx.x * 8 + wid) * 4;
  if (t0 < T) ldrows(t0, RA);
  for (; t0 < T; t0 += 2 * st2) {
    if (t0 + st2 < T) ldrows(t0 + st2, RB);
    dorows(t0, RA);
    if (t0 + st2 < T) { if (t0 + 2 * st2 < T) ldrows(t0 + 2 * st2, RA); dorows(t0 + st2, RB); }
  }
}
constexpr int FW_ACC = 0, FW_WQ = 8192, FW_WSC = 10240, FW_RS = 10304, FW_EID = 10368, FW_X = 14464, FW_STRIDE = 18688;
__device__ __forceinline__ void tok_ids_f(const char* wl, int k, int lane, TokE& in) {
  const u32x4* ep = (const u32x4*)(wl + FW_EID + k * 256 + (lane >> 3) * 32);
  in.e[0] = ep[0]; in.e[1] = ep[1];
}
template <bool UP> __device__ __forceinline__ void tok_gather_f(const Params& p, const unsigned char* base, int slab, int t, int k, int lane, const TokE& in, TokD<UP>& d, const char* wl) {
#pragma unroll
  for (int i = 0; i < 16; ++i) { const unsigned w = in.e[i >> 3][(i >> 1) & 3]; d.raw[i] = *(const u32x4*)(base + (size_t)((i & 1) ? (w >> 16) : (w & 0xffffu)) * 128); }
  if (UP) { d.aux = *(const u32x4*)(wl + FW_WQ + k * 128 + (lane >> 3) * 16);
    d.xr = *(const unsigned*)((const bf16_t*)(p.ws + OFF_X1B) + (size_t)t * 1024 + slab * 128 + (lane & 7) * 16 + 2 * (lane >> 3)); }
  else d.aux = *(const u32x4*)(wl + FW_X + k * 128 + (lane & 7) * 16);
}
template <bool UP> __device__ __forceinline__ void tok_compute_f(const Params& p, int slab, int t, int k, int lane, const TokD<UP>& d, char* wl) {
  if constexpr (UP) { const int g = lane >> 3, c = lane & 7; int r0, r1; up_dots(lane, d, r0, r1);
    const float ws = *(const float*)(wl + FW_WSC + k * 4);
    *(unsigned*)((bf16_t*)(p.ws + OFF_PO) + (size_t)t * 1024 + slab * 128 + c * 16 + 2 * g) = cvt_pk_bf16(fmaf((float)r0, ws, __uint_as_float(d.xr << 16)), fmaf((float)r1, ws, __uint_as_float(d.xr & 0xffff0000u)));
  } else { int r0, r1; down_dots_q(lane, d, r0, r1);
    int* a = (int*)(wl + FW_ACC + k * 512) + 2 * lane; a[0] += r0; a[1] += r1; }
}
template <bool UP> __device__ __forceinline__ void gather_wave_f(const Params& p, int slab, int t0, int ntok, int lane, char* wl) {
  const unsigned char* base = (const unsigned char*)(p.ws + (UP ? OFF_V8 : OFF_U8)) + (size_t)slab * (16384 * 128) + (lane & 7) * 16;
  TokE eA, eB; TokD<UP> dA, dB;
  tok_ids_f(wl, 0, lane, eA); tok_ids_f(wl, 1, lane, eB);
  tok_gather_f<UP>(p, base, slab, t0, 0, lane, eA, dA, wl);
  for (int k = 0; k < ntok; k += 2) {
    tok_gather_f<UP>(p, base, slab, t0 + k + 1, k + 1, lane, eB, dB, wl);
    tok_ids_f(wl, (k + 2 < ntok) ? k + 2 : 0, lane, eA);
    tok_compute_f<UP>(p, slab, t0 + k, k, lane, dA, wl);
    if (k + 2 < ntok) tok_gather_f<UP>(p, base, slab, t0 + k + 2, k + 2, lane, eA, dA, wl);
    tok_ids_f(wl, (k + 3 < ntok) ? k + 3 : 0, lane, eB);
    tok_compute_f<UP>(p, slab, t0 + k + 1, k + 1, lane, dB, wl);
  }
}
__device__ __forceinline__ void phase_peer_fused(const Params& p, char* lds) {
  const int tid = otid(), wid = tid >> 6, lane = tid & 63;
  constexpr int NTOK = 16;
  const int t0 = ((int)blockIdx.x * 8 + wid) * NTOK;
  char* wl = lds + 1024 + wid * FW_STRIDE;
  const int my = (int)(xcc_id() & 7u);
  { const u32x4* es = (const u32x4*)((const unsigned short*)(p.ws + OFF_EID) + (size_t)t0 * 128);
#pragma unroll
    for (int i = 0; i < 4; ++i) ((u32x4*)(wl + FW_EID))[lane + 64 * i] = es[lane + 64 * i];
    if (lane < NTOK) *(float*)(wl + FW_RS + lane * 4) = ((const float*)(p.ws + OFF_SSQ1))[t0 + lane]; }
#pragma unroll
  for (int k = 0; k < NTOK; ++k) ((int2*)(wl + FW_ACC + k * 512))[lane] = make_int2(0, 0);
  { u32x4 xn[4];
    auto xfetch = [&](int slab) {
#pragma unroll
      for (int i = 0; i < 4; ++i) xn[i] = *(const u32x4*)((const char*)(p.ws + OFF_X1B) + (size_t)(t0 + 4 * i + (lane >> 4)) * 2048 + slab * 256 + (lane & 15) * 16); };
    auto xstash = [&]() {
#pragma unroll
      for (int i = 0; i < 4; ++i) { const int tk = 4 * i + (lane >> 4);
        const float rs = rsqrtf(*(const float*)(wl + FW_RS + tk * 4) * (1.f / 1024.f) + EPS) * (127.f / XQ_CLAMP); int q[8];
#pragma unroll
        for (int e = 0; e < 4; ++e) { q[2 * e] = __float2int_rn(fminf(fmaxf(__uint_as_float(xn[i][e] << 16) * rs, -127.f), 127.f)); q[2 * e + 1] = __float2int_rn(fminf(fmaxf(__uint_as_float(xn[i][e] & 0xffff0000u) * rs, -127.f), 127.f)); }
        u32x2 w; w.x = (unsigned)(q[0] & 255) | ((unsigned)(q[1] & 255) << 8) | ((unsigned)(q[2] & 255) << 16) | ((unsigned)q[3] << 24);
        w.y = (unsigned)(q[4] & 255) | ((unsigned)(q[5] & 255) << 8) | ((unsigned)(q[6] & 255) << 16) | ((unsigned)q[7] << 24);
        *(u32x2*)(wl + FW_X + tk * 128 + (lane & 15) * 8) = w; } };
    xfetch(my & 7); xstash();
    for (int pass = 0; pass < 8; ++pass) {
      if (pass < 7) xfetch((my + pass + 1) & 7);
      gather_wave_f<false>(p, (my + pass) & 7, t0, NTOK, lane, wl);
      if (pass < 7) xstash();
    } }
  { const unsigned* gate = (const unsigned*)(p.ws + OFF_GATE);
    for (int k = 0; k < NTOK; ++k) { const int2 a = ((const int2*)(wl + FW_ACC + k * 512))[lane]; const u32x2 gt = *(const u32x2*)(gate + (size_t)(t0 + k) * 128 + 2 * lane);
      float s0 = (float)a.x * (XQ_CLAMP / 127.f), s1 = (float)a.y * (XQ_CLAMP / 127.f);
      s0 *= __uint_as_float(gt.x & 0xffff0000u); s1 *= __uint_as_float(gt.y & 0xffff0000u);
      const float h0 = __uint_as_float(gt.x << 16) * 0.5f * s0 * (1.f + erff(s0 * 0.70710678118654752f));
      const float h1 = __uint_as_float(gt.y << 16) * 0.5f * s1 * (1.f + erff(s1 * 0.70710678118654752f));
      const float am = wave_max(fmaxf(fabsf(h0), fabsf(h1)));
      const float inv = am > 0.f ? 127.f / am : 0.f;
      const int q0 = __float2int_rn(h0 * inv), q1 = __float2int_rn(h1 * inv);
      *(unsigned short*)(wl + FW_WQ + k * 128 + 2 * lane) = (unsigned short)((q0 & 255) | ((q1 & 255) << 8));
      if (lane == 0) *(float*)(wl + FW_WSC + k * 4) = am * (1.f / 127.f); } }
  for (int pass = 0; pass < 8; ++pass) gather_wave_f<true>(p, (my + pass) & 7, t0, NTOK, lane, wl);
  asm volatile("s_waitcnt vmcnt(0)" ::: "memory");
  { const bf16_t* po = (const bf16_t*)(p.ws + OFF_PO);
    for (int k0 = 0; k0 < NTOK; k0 += 4) {
      unsigned long long pw[4][4];
#pragma unroll
      for (int r = 0; r < 4; ++r)
#pragma unroll
        for (int i = 0; i < 4; ++i) pw[r][i] = __hip_atomic_load((const unsigned long long*)(po + (size_t)(t0 + k0 + r) * 1024 + (lane + 64 * i) * 4), __ATOMIC_RELAXED, __HIP_MEMORY_SCOPE_AGENT);
      float ss[4];
#pragma unroll
      for (int r = 0; r < 4; ++r) { float s_ = 0.f;
#pragma unroll
        for (int i = 0; i < 4; ++i) { const unsigned lo = (unsigned)pw[r][i], hi = (unsigned)(pw[r][i] >> 32);
          const float a = __uint_as_float(lo << 16), b = __uint_as_float(lo & 0xffff0000u), c = __uint_as_float(hi << 16), d = __uint_as_float(hi & 0xffff0000u);
          s_ += a * a + b * b + c * c + d * d; }
        ss[r] = rsqrtf(wave_sum(s_) * (1.f / 1024.f) + EPS); }
#pragma unroll
      for (int i = 0; i < 4; ++i) { const f32x4 g4 = *(const f32x4*)(p.fg + (lane + 64 * i) * 4);
#pragma unroll
        for (int r = 0; r < 4; ++r) { const unsigned lo = (unsigned)pw[r][i], hi = (unsigned)(pw[r][i] >> 32);
          const f32x4 v = (f32x4){__uint_as_float(lo << 16), __uint_as_float(lo & 0xffff0000u), __uint_as_float(hi << 16), __uint_as_float(hi & 0xffff0000u)};
          ((f32x4*)(p.out + (size_t)(t0 + k0 + r) * 1024))[lane + 64 * i] = v * g4 * ss[r]; } }
    } }
}
}


namespace topk {
using att::f32x16; using att::ld8;
__device__ __forceinline__ void ce(float& a, float& b) {
  float mx, mn; asm("v_max_f32 %0, %1, %2" : "=v"(mx) : "v"(a), "v"(b)); asm("v_min_f32 %0, %1, %2" : "=v"(mn) : "v"(a), "v"(b)); a = mx; b = mn; }
__device__ __forceinline__ void sort16(float (&a)[16]) {
#pragma unroll
  for (int p = 1; p < 16; p *= 2)
#pragma unroll
    for (int k = p; k >= 1; k /= 2)
#pragma unroll
      for (int j = k % p; j <= 15 - k; j += 2 * k)
#pragma unroll
        for (int i = 0; i < (k < 16 - j - k ? k : 16 - j - k); ++i)
          if ((i + j) / (2 * p) == (i + j + k) / (2 * p)) ce(a[i + j], a[i + j + k]);
}
__device__ __forceinline__ void merge16(float (&a)[16], const float (&b)[16]) {
#pragma unroll
  for (int i = 0; i < 16; ++i) { float mx; asm("v_max_f32 %0, %1, %2" : "=v"(mx) : "v"(a[i]), "v"(b[15 - i])); a[i] = mx; }
#pragma unroll
  for (int j = 8; j > 0; j >>= 1)
#pragma unroll
    for (int i = 0; i < 16; ++i) { const int l = i ^ j; if (l > i) ce(a[i], a[l]); }
}
#define TKSWZ(row, colB) ((row) * 256 + ((colB) ^ (((row) & 7) << 4)))
__device__ __forceinline__ void stage_keys(const Params& p, int h, char* lds) {
  const bf16_t* kb = (const bf16_t*)(p.ws + OFF_KEYS) + (size_t)h * 2 * 128 * 128;
#pragma unroll
  for (int i = 0; i < 8; ++i) { const int q = otid() + 512 * i, row = q >> 4, c8 = (q & 15) * 8;
    *(bf16x8*)(lds + TKSWZ(row, c8 * 2)) = ld8(kb + (size_t)row * 128 + c8); }
}
__device__ __forceinline__ void load_q(const Params& p, int it, int ph, int wid, int lane, bf16x8 (&qf)[8]) {
  const int r32 = lane & 31, hi = lane >> 5, h = it & 7, t0 = (it >> 3) * 256 + wid * 32;
  const bf16_t* q = (const bf16_t*)(p.ws + OFF_Q) + (size_t)(t0 + r32) * 2048 + h * 256 + ph * 128 + hi * 8;
#pragma unroll
  for (int i = 0; i < 8; ++i) qf[i] = ld8(q + i * 16);
}
__device__ __forceinline__ void item(const Params& p, int it, int itn, int wid, int lane, const char* lds, bf16x8 (&qf)[8]) {
  const int r32 = lane & 31, hi = lane >> 5, h = it & 7, t0 = (it >> 3) * 256 + wid * 32;
  float L[2][16];
#pragma unroll
  for (int ph = 0; ph < 2; ++ph) {
    f32x16 acc[4] = {};
    bf16x8 af[2][4];
#pragma unroll
    for (int kb = 0; kb < 4; ++kb) af[0][kb] = *(const bf16x8*)(lds + TKSWZ(ph * 128 + kb * 32 + r32, (hi * 8) * 2));
#pragma unroll
    for (int ks = 0; ks < 8; ++ks) {
      if (ks + 1 < 8) {
#pragma unroll
        for (int kb = 0; kb < 4; ++kb) af[(ks + 1) & 1][kb] = *(const bf16x8*)(lds + TKSWZ(ph * 128 + kb * 32 + r32, ((ks + 1) * 16 + hi * 8) * 2)); }
#pragma unroll
      for (int kb = 0; kb < 4; ++kb) acc[kb] = __builtin_amdgcn_mfma_f32_32x32x16_bf16(af[ks & 1][kb], qf[ks], acc[kb], 0, 0, 0);
      __builtin_amdgcn_sched_barrier(0); }
    if (ph == 0) load_q(p, it, 1, wid, lane, qf); else if (itn >= 0) load_q(p, itn, 0, wid, lane, qf);
    float g[4][16];
#pragma unroll
    for (int kb = 0; kb < 4; ++kb)
#pragma unroll
      for (int r = 0; r < 16; ++r) g[kb][r] = __uint_as_float((__float_as_uint(acc[kb][r]) & 0xFFFFFF80u) | (unsigned)(kb * 32 + (r & 3) + 8 * (r >> 2)));
    sort16(g[0]); sort16(g[1]); sort16(g[2]); sort16(g[3]);
    merge16(g[0], g[1]); merge16(g[2], g[3]); merge16(g[0], g[2]);
#pragma unroll
    for (int i = 0; i < 16; ++i) L[ph][i] = __uint_as_float(__float_as_uint(g[0][i]) | (unsigned)(hi * 4));
  }
  float A[16], B[16];
  { float M1[16], M2[16];
#pragma unroll
    for (int i = 0; i < 16; ++i) { auto r = __builtin_amdgcn_permlane32_swap(__float_as_uint(L[0][i]), __float_as_uint(L[1][i]), false, false); M1[i] = __uint_as_float(r[0]); M2[i] = __uint_as_float(r[1]); }
    merge16(M1, M2);
#pragma unroll
    for (int i = 0; i < 16; ++i) { auto r = __builtin_amdgcn_permlane32_swap(__float_as_uint(M1[i]), __float_as_uint(M1[i]), false, false); A[i] = __uint_as_float(r[0]); B[i] = __uint_as_float(r[1]); } }
  unsigned ia[16], ib[16];
#pragma unroll
  for (int i = 0; i < 16; ++i) { ia[i] = (__float_as_uint(A[i]) & 0x7Fu) << 7; ib[i] = __float_as_uint(B[i]) & 0x7Fu; }
#define CAND(i, j) __uint_as_float((__float_as_uint(A[i] + B[j]) & 0xFFFFC000u) | ia[i] | ib[j])
  const float NEG = -3.0e38f;
  float G0[16], G1[16], G2[16], G3[16];
#pragma unroll
  for (int j = 0; j < 16; ++j) G0[j] = CAND(0, j);
#pragma unroll
  for (int j = 0; j < 8; ++j) G1[j] = CAND(1, j);
#pragma unroll
  for (int j = 0; j < 5; ++j) G1[8 + j] = CAND(2, j);
#pragma unroll
  for (int j = 0; j < 3; ++j) G1[13 + j] = CAND(3, j);
  G2[0] = CAND(3, 3); G2[1] = CAND(4, 0); G2[2] = CAND(4, 1); G2[3] = CAND(4, 2); G2[4] = CAND(5, 0); G2[5] = CAND(5, 1); G2[6] = CAND(6, 0); G2[7] = CAND(6, 1);
  G2[8] = CAND(7, 0); G2[9] = CAND(7, 1); G2[10] = CAND(8, 0); G2[11] = CAND(9, 0); G2[12] = CAND(10, 0); G2[13] = CAND(11, 0); G2[14] = CAND(12, 0); G2[15] = CAND(13, 0);
  G3[0] = CAND(14, 0); G3[1] = CAND(15, 0);
#pragma unroll
  for (int j = 2; j < 16; ++j) G3[j] = NEG;
#undef CAND
  ce(G3[0], G3[1]);
  sort16(G0); sort16(G1); sort16(G2);
  merge16(G0, G1); merge16(G2, G3); merge16(G0, G2);
  float e[16], sum = 0.f; const float s0 = __uint_as_float(__float_as_uint(G0[0]) & 0xFFFFC000u);
#pragma unroll
  for (int k = 0; k < 16; ++k) { e[k] = __expf(__uint_as_float(__float_as_uint(G0[k]) & 0xFFFFC000u) - s0); sum += e[k]; }
  const float inv = 1.f / sum;
  unsigned short* eo = (unsigned short*)(p.ws + OFF_EID) + (size_t)(t0 + r32) * 128 + h * 16 + hi * 8; float* go = (float*)(p.ws + OFF_GATE) + (size_t)(t0 + r32) * 128 + h * 16 + hi * 8;
  u32x4 e0; f32x4 g0, g1; const unsigned hm = (unsigned)(-hi);
#define SELU(a, b) (__float_as_uint(b) ^ ((__float_as_uint(a) ^ __float_as_uint(b)) & hm))
#pragma unroll
  for (int k = 0; k < 4; ++k) { e0[k] = (SELU(G0[8 + 2 * k], G0[2 * k]) & 0x3FFFu) | ((SELU(G0[9 + 2 * k], G0[2 * k + 1]) & 0x3FFFu) << 16);
    g0[k] = __uint_as_float(SELU(e[8 + k], e[k])) * inv; g1[k] = __uint_as_float(SELU(e[12 + k], e[4 + k])) * inv; }
#undef SELU
  const float* sc_ = (const float*)(p.ws + OFF_USC); u32x4 w0, w1;
#pragma unroll
  for (int k = 0; k < 4; ++k) { const unsigned ea = e0[k >> 1] >> (16 * (k & 1)) & 0xffffu, eb = e0[2 + (k >> 1)] >> (16 * (k & 1)) & 0xffffu;
    w0[k] = cvt_pk_bf16(g0[k] * sc_[16384 + ea], sc_[ea]); w1[k] = cvt_pk_bf16(g1[k] * sc_[16384 + eb], sc_[eb]); }
  *(u32x4*)eo = e0; *(u32x4*)go = w0; *(u32x4*)(go + 4) = w1;
}
}

template <int PH> __device__ __forceinline__ void run_phase(const Params& p, char* smem) {
  if constexpr (PH == 0) phase_prep(p, smem);
  if constexpr (PH == 1) {
    pg8::Gemm g{(const bf16_t*)(p.ws + OFF_XB), (const bf16_t*)(p.ws + OFF_WIN), T, 3072, 1024};
    pg8::BalancedOrder So; So.init(T, 3072, gridDim.x, blockIdx.x);
    EpiInproj E{p.ws, (const float*)(p.ws + OFF_RSTD0), (unsigned*)(p.ws + OFF_KN)};
    pg8::gemm_phase(( LAS unsigned char*)smem, g, So, E);
  }
  if constexpr (PH == 2) phase_attn(p, smem);
  if constexpr (PH == 3) ret::phase_states(p, smem);
  if constexpr (PH == 4) ret::phase_scan(p);
  if constexpr (PH == 5) ret::phase_retout(p, smem);
  if constexpr (PH == 6) {
    pg8::Gemm g{(const bf16_t*)(p.ws + OFF_MIX), (const bf16_t*)(p.ws + OFF_WOUT), T, 1024, 1024};
    pg8::StaticOrder So; So.init(T, 1024, gridDim.x, blockIdx.x);
    EpiOutproj E{(const bf16_t*)(p.ws + OFF_XB), (bf16_t*)(p.ws + OFF_X1B), (float*)(p.ws + OFF_SSQ1)};
    pg8::gemm_phase((LAS unsigned char*)smem, g, So, E);
  }
  if constexpr (PH == 8) {
    const int tid_ = otid(), wid = tid_ >> 6, lane = tid_ & 63; int hcur = -1; bf16x8 qf[8];
    pg8::StaticOrder So; So.init(T, 2048, gridDim.x, blockIdx.x);
    asm volatile("s_waitcnt vmcnt(0)" ::: "memory"); __syncthreads();
    unsigned long long w0, w1;
    { unsigned key[8];
#pragma unroll
      for (int i = 0; i < 8; ++i) { pg8::Unit t; key[i] = So.next(i, t) ? (((unsigned)t.pn << 27) | ((unsigned)i << 24) | (unsigned)((t.pm << 3) | t.pn)) : 0xffffffffu; }
#define SC(a, b) do { const unsigned lo_ = key[a] < key[b] ? key[a] : key[b], hi_ = key[a] < key[b] ? key[b] : key[a]; key[a] = lo_; key[b] = hi_; } while (0)
      SC(0, 1); SC(2, 3); SC(4, 5); SC(6, 7); SC(0, 2); SC(1, 3); SC(4, 6); SC(5, 7); SC(1, 2); SC(5, 6); SC(0, 4); SC(1, 5); SC(2, 6); SC(3, 7); SC(2, 4); SC(3, 5); SC(1, 2); SC(3, 4); SC(5, 6);
#undef SC
      w0 = w1 = 0ull;
#pragma unroll
      for (int i = 0; i < 4; ++i) { w0 |= (unsigned long long)(key[i] == 0xffffffffu ? 0xffffu : (key[i] & 0x3ffu)) << (16 * i); w1 |= (unsigned long long)(key[4 + i] == 0xffffffffu ? 0xffffu : (key[4 + i] & 0x3ffu)) << (16 * i); } }
    auto item_of = [&](int k) -> int {
      if (k < 8) { const unsigned v = (unsigned)(((k < 4 ? w0 : w1) >> (16 * (k & 3))) & 0xffffull); return v == 0xffffu ? -1 : (int)v; }
      pg8::Unit t; return So.next(k, t) ? ((t.pm << 3) | t.pn) : -1; };
    int it = item_of(0);
    if (it >= 0) topk::load_q(p, it, 0, wid, lane, qf);
    for (int k = 0; it >= 0; ++k) {
      const int itn = item_of(k + 1);
      if ((it & 7) != hcur) { __syncthreads(); hcur = it & 7; topk::stage_keys(p, hcur, smem); __syncthreads(); }
      topk::item(p, it, itn, wid, lane, smem, qf);
      it = itn;
    }
    __syncthreads();
  }
  if constexpr (PH == 9) peer::phase_gather<false>(p, smem);
  if constexpr (PH == 10) peer::phase_finish(p);
  if constexpr (PH == 11) peer::phase_gather<true>(p, smem);
  if constexpr (PH == 12) peer::phase_final(p);
  if constexpr (PH == 7) {
    pg8::Gemm g{(const bf16_t*)(p.ws + OFF_X1B), (const bf16_t*)(p.ws + OFF_WQ), T, 2048, 1024};
    pg8::StaticOrder So; So.init(T, 2048, gridDim.x, blockIdx.x);
    EpiQ E{(const float*)(p.ws + OFF_SSQ1), (bf16_t*)(p.ws + OFF_Q)};
    pg8::gemm_phase((LAS unsigned char*)smem, g, So, E);
  }
}


#define XB_TMO      128
#define XB_XCNT(j)  (256  + 64 * (j))
#define XB_XSUB(j)  (1280 + 64 * (j))
#define XB_XGEN(j)  (2304 + 64 * (j))
#define XB_TOP      3328
#define XB_TOPGEN   3392
#define XCD_BAR_WORDS 3456
#define XB_SPIN_CAP (1u << 22)
__device__ __forceinline__ unsigned xb_ld(unsigned* p)              { return __hip_atomic_load(p, __ATOMIC_RELAXED, __HIP_MEMORY_SCOPE_AGENT); }
__device__ __forceinline__ unsigned xb_add(unsigned* p, unsigned v) { return __hip_atomic_fetch_add(p, v, __ATOMIC_RELAXED, __HIP_MEMORY_SCOPE_AGENT); }
__device__ __forceinline__ unsigned xb_xcc_id() { return (unsigned)__builtin_amdgcn_s_getreg((3 << 11) | 20) & 0xFu; }
#define XB_SPIN(cond, bar) do { unsigned _sp = 0; while (cond) { __builtin_amdgcn_s_sleep(1); \
    if ((++_sp & 255u) == 0u) { if (xb_ld(&(bar)[XB_TMO])) break; if (_sp > XB_SPIN_CAP) { atomicAdd(&(bar)[XB_TMO], 1u); break; } } } } while (0)
struct XcdBarrier { unsigned* bar; unsigned x; volatile LAS unsigned* st; };
__device__ __forceinline__ XcdBarrier xcd_barrier_post(unsigned* bar, volatile LAS unsigned* st) {
  XcdBarrier b; b.bar = bar; b.x = xb_xcc_id(); b.st = st;
  if (threadIdx.x == 0) (void)xb_add(&bar[XB_XCNT(b.x)], 1u);
  return b;
}
__device__ __forceinline__ void xcd_barrier_complete(unsigned* bar, unsigned x, unsigned& nloc, unsigned& nx) {
  const unsigned G = gridDim.x * gridDim.y * gridDim.z;
  unsigned sum, cnt, mine, sp = 0u;
  for (;;) {
    sum = 0u; cnt = 0u; mine = 0u;
#pragma unroll
    for (unsigned j = 0; j < 16; ++j) { const unsigned c = xb_ld(&bar[XB_XCNT(j)]); sum += c; cnt += (c > 0u) ? 1u : 0u; mine = (j == x) ? c : mine; }
    if (sum == G) break;
    __builtin_amdgcn_s_sleep(1);
    if ((++sp & 255u) == 0u) { if (xb_ld(&bar[XB_TMO])) break; if (sp > XB_SPIN_CAP) { atomicAdd(&bar[XB_TMO], 1u); break; } }
  }
  nloc = mine > 0u ? mine : 1u; nx = cnt > 0u ? cnt : 1u;
}
__device__ __forceinline__ void xcd_barrier(const XcdBarrier& b) {
  asm volatile("s_waitcnt vmcnt(0)" ::: "memory");
  __syncthreads();
  if (threadIdx.x == 0) {
    unsigned* bar = b.bar;
    __builtin_amdgcn_s_waitcnt(0);
    unsigned nloc = b.st[0], nx = b.st[1];
    if (nloc == 0u) { xcd_barrier_complete(bar, b.x, nloc, nx); b.st[0] = nloc; b.st[1] = nx; }
    const unsigned old = xb_add(&bar[XB_XSUB(b.x)], 1u);
    const unsigned gen = old / nloc;
    if (old + 1u == (gen + 1u) * nloc) {
      __builtin_amdgcn_fence(__ATOMIC_RELEASE, "agent");
      asm volatile("s_waitcnt vmcnt(0)" ::: "memory");
      const unsigned og = xb_add(&bar[XB_TOP], 1u);
      const unsigned tg = og / nx;
      if (og + 1u == (tg + 1u) * nx) xb_add(&bar[XB_TOPGEN], 1u);
      else XB_SPIN(xb_ld(&bar[XB_TOPGEN]) == tg, bar);
      __builtin_amdgcn_fence(__ATOMIC_ACQUIRE, "agent");
      xb_add(&bar[XB_XGEN(b.x)], 1u);
      asm volatile("s_waitcnt vmcnt(0)" ::: "memory");
    } else {
      XB_SPIN(xb_ld(&bar[XB_XGEN(b.x)]) == gen, bar);
      __builtin_amdgcn_fence(__ATOMIC_ACQUIRE, "agent");
      asm volatile("s_waitcnt vmcnt(0)" ::: "memory");
    }
  }
  __syncthreads();
}

template <int PH> __global__ __launch_bounds__(512, 2) void k_phase(Params p) {
  extern __shared__ __attribute__((aligned(16))) char smem[];
  run_phase<PH>(p, smem);
}
__global__ __launch_bounds__(512, 2) void mega(Params p) {
  extern __shared__ __attribute__((aligned(16))) char smem[];
  cooperative_groups::grid_group grid = cooperative_groups::this_grid();
  volatile LAS unsigned* st = (volatile LAS unsigned*)(LAS unsigned char*)(smem + LDS_ST_OFF);
  if (threadIdx.x == 0) { st[0] = 0u; st[1] = 0u; st[2] = 0u; st[3] = 0u; }
  __syncthreads();
  const XcdBarrier xb = xcd_barrier_post((unsigned*)(p.ws + OFF_BAR), st);
#ifndef PROBE_DUP
#define PROBE_DUP -1
#endif
#define DUP(k) do { if (PROBE_DUP == (k)) { xcd_barrier(xb); run_phase<(k)>(p, smem); } } while (0)
  run_phase<0>(p, smem); DUP(0); if (p.coop_sync) grid.sync(); xcd_barrier(xb);
  run_phase<1>(p, smem); DUP(1); xcd_barrier(xb);
  phase_attn_host<0>(p, smem); xcd_barrier(xb);
  run_phase<4>(p, smem); xcd_barrier(xb);
  phase_attn_host<1>(p, smem); xcd_barrier(xb);
  if (PROBE_DUP == 345) { run_phase<3>(p, smem); xcd_barrier(xb); run_phase<4>(p, smem); xcd_barrier(xb); run_phase<5>(p, smem); xcd_barrier(xb); }
  run_phase<6>(p, smem); xcd_barrier(xb);
  run_phase<7>(p, smem); run_phase<8>(p, smem); if (PROBE_DUP == 8) run_phase<8>(p, smem); if (PROBE_DUP == 78) { xcd_barrier(xb); run_phase<7>(p, smem); run_phase<8>(p, smem); } xcd_barrier(xb);
  if (gridDim.x * 128u == (unsigned)T) peer::phase_peer_fused(p, smem);
  else {
    run_phase<9>(p, smem); xcd_barrier(xb);
    run_phase<10>(p, smem); xcd_barrier(xb);
    run_phase<11>(p, smem); xcd_barrier(xb);
    run_phase<12>(p, smem);
  }
}

}


extern "C" void kernel_launch(void* const* d_in, const int* in_sizes, int n_in, void* d_out, int out_size, void* d_ws, size_t ws_size, hipStream_t stream) {
  Params p{};
  p.x = (const float*)d_in[0]; p.attn_g = (const float*)d_in[1]; p.w_in = (const float*)d_in[2]; p.dlam = (const float*)d_in[3]; p.dng = (const float*)d_in[4];
  p.rld = (const float*)d_in[5]; p.rng_ = (const float*)d_in[6]; p.w_out = (const float*)d_in[7]; p.ffn_g = (const float*)d_in[8]; p.wq = (const float*)d_in[9];
  p.keys = (const float*)d_in[10]; p.pu = (const float*)d_in[11]; p.pv = (const float*)d_in[12]; p.fg = (const float*)d_in[13];
  p.out = (float*)d_out; p.ws = (char*)d_ws;
  if (ws_size < WS_NEED) { fprintf(stderr, "ws too small: %zu\n", ws_size); return; }
  static int grid_blocks = 0;
  if (!grid_blocks) {
    (void)hipFuncSetAttribute((const void*)mega, hipFuncAttributeMaxDynamicSharedMemorySize, LDS_BYTES);
    int dev = 0, cus = 0, per_cu = 0;
    (void)hipGetDevice(&dev); (void)hipDeviceGetAttribute(&cus, hipDeviceAttributeMultiprocessorCount, dev);
    (void)hipOccupancyMaxActiveBlocksPerMultiprocessor(&per_cu, (const void*)mega, 512, LDS_BYTES);
    if (per_cu > 1) per_cu = 1;
    grid_blocks = cus * per_cu;
    if (grid_blocks <= 0) { fprintf(stderr, "occupancy query failed: cus %d per_cu %d\n", cus, per_cu); grid_blocks = 0; return; }
  }
  (void)hipMemsetAsync((char*)d_ws + OFF_BAR, 0, 16 * 1024, stream);
  void* args[] = {&p};
  hipError_t e = hipLaunchCooperativeKernel((const void*)mega, dim3(grid_blocks), dim3(512), args, LDS_BYTES, stream);
  if (e != hipSuccess) fprintf(stderr, "cooperative launch failed: %s (grid %d)\n", hipGetErrorString(e), grid_blocks);
}
```
